# Optimizing an MI355X kernel written in HIP

```python
import math
import jax, jax.numpy as jnp
from jax import lax
import numpy as np

D_MODEL = 1024
BATCH = 8
SEQ = 4096
DEPTH = 2

A_HEADS = 8
A_HEAD_DIM = 64
A_ROT_DIM = A_HEAD_DIM // 4
A_WIDTH = A_HEADS * A_HEAD_DIM
MOBA_BLOCK = 256
MOBA_TOPK = 3
MOBA_Q_CHUNK = 16
B_HEADS = 8
B_NOPE_DIM = 64
B_ROPE_DIM = 32
B_QK_DIM = B_NOPE_DIM + B_ROPE_DIM
B_V_DIM = 64
B_WIDTH = B_HEADS * B_V_DIM
B_Q_RANK = 384
B_KV_RANK = 256
ATTN_Q_BLOCK = 128
ROPE_THETA = 500000.0
N_BRANCH = 2
EPS = 1e-6
NEG = -1e30
D_FF = 2816
N_EXPERTS = 8
EXPERT_TOPK = 2
N_DENSE = (DEPTH + 1) // 2
N_MOE = DEPTH // 2

IN_SPLITS = (A_WIDTH, A_WIDTH, A_WIDTH, B_Q_RANK, B_KV_RANK, B_ROPE_DIM, N_BRANCH * D_MODEL)
IN_WIDTH = sum(IN_SPLITS)
SPLIT_IDX = tuple(int(v) for v in np.cumsum(IN_SPLITS)[:-1])

kernel_name = "hybrid_moba_mla_gated_moe_block"


def rms_norm(x, g):
    xf = x.astype(jnp.float32)
    y = xf * lax.rsqrt(jnp.mean(xf * xf, axis=-1, keepdims=True) + EPS)
    return (y * g.astype(jnp.float32)).astype(x.dtype)


def rope_tables(seq, rot_dim):
    inv = ROPE_THETA ** (-jnp.arange(0, rot_dim, 2, dtype=jnp.float32) / rot_dim)
    ang = jnp.arange(seq, dtype=jnp.float32)[:, None] * inv[None, :]
    return jnp.cos(ang), jnp.sin(ang)


def apply_rope(x, cos, sin):
    xf = x.astype(jnp.float32)
    x1, x2 = jnp.split(xf, 2, axis=-1)
    return jnp.concatenate([x1 * cos - x2 * sin, x2 * cos + x1 * sin], axis=-1).astype(x.dtype)


def rope_slice(x, start, rot_dim, cos, sin):
    return jnp.concatenate([x[..., :start],
                            apply_rope(x[..., start:start + rot_dim], cos, sin),
                            x[..., start + rot_dim:]], axis=-1)


def moba_attention(q, k, v):
    b, h, s, dh = q.shape
    nb = -(-s // MOBA_BLOCK)
    pad = nb * MOBA_BLOCK - s
    kp = jnp.pad(k, ((0, 0), (0, 0), (0, pad), (0, 0))).reshape(b, h, nb, MOBA_BLOCK, dh)
    vp = jnp.pad(v, ((0, 0), (0, 0), (0, pad), (0, 0))).reshape(b, h, nb, MOBA_BLOCK, dh)
    k_mean = jnp.mean(kp.astype(jnp.float32), axis=3)
    pos = jnp.arange(s)
    q_blk = pos // MOBA_BLOCK
    gate = jnp.einsum('bhsd,bhnd->bhsn', q.astype(jnp.float32), k_mean)
    past = jnp.arange(nb)[None, :] < q_blk[:, None]
    gate = jnp.where(past, gate, -jnp.inf)
    topk = min(MOBA_TOPK, nb)
    _, sel = lax.top_k(gate, topk)
    own = jnp.broadcast_to(q_blk.astype(sel.dtype), (b, h, s))[..., None]
    sel = jnp.concatenate([sel, own], axis=-1)
    n_slot = topk + 1
    r = jnp.arange(n_slot)
    slot_ok = (r[None, :] == topk) | (r[None, :] < q_blk[:, None])

    base = (jnp.arange(b)[:, None] * h + jnp.arange(h)[None, :]) * nb
    flat_idx = base[:, :, None, None].astype(sel.dtype) + sel
    k_flat = kp.reshape(b * h * nb, MOBA_BLOCK, dh)
    v_flat = vp.reshape(b * h * nb, MOBA_BLOCK, dh)

    nc = s // MOBA_Q_CHUNK
    c = MOBA_Q_CHUNK
    to_chunks = lambda t: t.reshape(b, h, nc, c, *t.shape[3:]).transpose(2, 0, 1, 3, *range(4, t.ndim + 1))
    q_c = to_chunks(q)
    fidx_c = to_chunks(flat_idx)
    sel_c = to_chunks(sel)
    ok_c = slot_ok.reshape(nc, c, n_slot)
    t_c = pos.reshape(nc, c)
    scale = 1.0 / math.sqrt(dh)
    p_off = jnp.arange(MOBA_BLOCK)

    def chunk_fn(args):
        qc, fidx, selc, okc, tc = args
        kg = jnp.take(k_flat, fidx, axis=0)
        vg = jnp.take(v_flat, fidx, axis=0)
        sc = jnp.einsum('bhcd,bhcrpd->bhcrp', qc, kg,
                        preferred_element_type=jnp.float32) * scale
        kpos = selc[..., None] * MOBA_BLOCK + p_off
        valid = okc[None, None, :, :, None] & (kpos <= tc[None, None, :, None, None])
        sc = jnp.where(valid, sc, NEG)
        pr = jax.nn.softmax(sc.reshape(b, h, c, -1), axis=-1).reshape(sc.shape)
        return jnp.einsum('bhcrp,bhcrpd->bhcd', pr.astype(vg.dtype), vg)

    out = lax.map(chunk_fn, (q_c, fidx_c, sel_c, ok_c, t_c))
    return out.transpose(1, 2, 0, 3, 4).reshape(b, h, s, dh)


def causal_attention(q, k, v):
    b, h, s, d = q.shape
    nq = s // ATTN_Q_BLOCK
    q_b = q.reshape(b, h, nq, ATTN_Q_BLOCK, d).transpose(2, 0, 1, 3, 4)
    kpos = jnp.arange(s)
    scale = 1.0 / math.sqrt(d)

    def blk(args):
        qc, i = args
        sc = jnp.einsum('bhqd,bhkd->bhqk', qc, k, preferred_element_type=jnp.float32) * scale
        qpos = i * ATTN_Q_BLOCK + jnp.arange(ATTN_Q_BLOCK)
        sc = jnp.where(kpos[None, :] <= qpos[:, None], sc, NEG)
        pr = jax.nn.softmax(sc, axis=-1)
        return jnp.einsum('bhqk,bhkd->bhqd', pr.astype(v.dtype), v)

    out = lax.map(blk, (q_b, jnp.arange(nq)))
    return out.transpose(1, 2, 0, 3, 4).reshape(b, h, s, -1)


def token_mixer(x, attn_norm, w_in, moba_qn, moba_kn, cq_norm, w_uq, ckv_norm, w_ukv,
                mla_qn, mla_kn, w_br_a, w_br_b, w_out):
    b, s, _ = x.shape
    hn = rms_norm(x, attn_norm)
    proj = hn @ w_in
    qa, ka, va, cq, ckv, kr, gates = jnp.split(proj, SPLIT_IDX, axis=-1)
    heads = lambda t, n: t.reshape(b, s, n, -1).transpose(0, 2, 1, 3)

    cos_a, sin_a = rope_tables(s, A_ROT_DIM)
    qa = rope_slice(rms_norm(heads(qa, A_HEADS), moba_qn), 0, A_ROT_DIM, cos_a, sin_a)
    ka = rope_slice(rms_norm(heads(ka, A_HEADS), moba_kn), 0, A_ROT_DIM, cos_a, sin_a)
    va = heads(va, A_HEADS)
    ya = moba_attention(qa, ka, va)
    ya = ya.transpose(0, 2, 1, 3).reshape(b, s, A_WIDTH)

    cos_b, sin_b = rope_tables(s, B_ROPE_DIM)
    qb = heads(rms_norm(cq, cq_norm) @ w_uq, B_HEADS)
    kv = heads(rms_norm(ckv, ckv_norm) @ w_ukv, B_HEADS)
    k_nope, vb = jnp.split(kv, [B_NOPE_DIM], axis=-1)
    k_rope = jnp.broadcast_to(kr[:, None], (b, B_HEADS, s, B_ROPE_DIM))
    kb = jnp.concatenate([k_nope, k_rope], axis=-1)
    qb = rope_slice(rms_norm(qb, mla_qn), B_NOPE_DIM, B_ROPE_DIM, cos_b, sin_b)
    kb = rope_slice(rms_norm(kb, mla_kn), B_NOPE_DIM, B_ROPE_DIM, cos_b, sin_b)
    yb = causal_attention(qb, kb, vb)
    yb = yb.transpose(0, 2, 1, 3).reshape(b, s, B_WIDTH)

    g_a, g_b = jnp.split(gates, 2, axis=-1)
    merged = jax.nn.sigmoid(g_a) * (ya @ w_br_a) + jax.nn.sigmoid(g_b) * (yb @ w_br_b)
    return merged @ w_out


def swiglu(h, w_gu, w_down):
    g, u = jnp.split(h @ w_gu, 2, axis=-1)
    return (jax.nn.silu(g) * u) @ w_down


def moe_swiglu(h, router_w, w_gu, w_down):
    logits = jnp.einsum('bsd,de->bse', h, router_w, preferred_element_type=jnp.float32)
    top_v, top_i = lax.top_k(logits, EXPERT_TOPK)
    probs = jax.nn.softmax(top_v, axis=-1)
    gate = jnp.einsum('bsk,bske->bse', probs,
                      jax.nn.one_hot(top_i, N_EXPERTS, dtype=jnp.float32))
    y = jnp.zeros_like(h)
    for e in range(N_EXPERTS):
        y = y + gate[..., e:e + 1].astype(h.dtype) * swiglu(h, w_gu[e], w_down[e])
    return y


def setup_inputs(seed: int = 0) -> dict:
    key = jax.random.key(seed)
    ks = jax.random.split(key, 24)
    f32 = jnp.float32

    def w(k, shape, fan_in):
        return jax.random.normal(k, shape, f32) * (fan_in ** -0.5)

    def g(k, shape):
        return 1.0 + 0.1 * jax.random.normal(k, shape, f32)

    return {
        "x": jax.random.normal(ks[0], (BATCH, SEQ, D_MODEL), f32),
        "attn_norm": g(ks[1], (DEPTH, D_MODEL)),
        "w_in": w(ks[2], (DEPTH, D_MODEL, IN_WIDTH), D_MODEL),
        "moba_q_norm": g(ks[3], (DEPTH, A_HEAD_DIM)),
        "moba_k_norm": g(ks[4], (DEPTH, A_HEAD_DIM)),
        "mla_cq_norm": g(ks[5], (DEPTH, B_Q_RANK)),
        "w_uq": w(ks[6], (DEPTH, B_Q_RANK, B_HEADS * B_QK_DIM), B_Q_RANK),
        "mla_ckv_norm": g(ks[7], (DEPTH, B_KV_RANK)),
        "w_ukv": w(ks[8], (DEPTH, B_KV_RANK, B_HEADS * (B_NOPE_DIM + B_V_DIM)), B_KV_RANK),
        "mla_q_norm": g(ks[9], (DEPTH, B_QK_DIM)),
        "mla_k_norm": g(ks[10], (DEPTH, B_QK_DIM)),
        "w_branch_a": w(ks[11], (DEPTH, A_WIDTH, D_MODEL), A_WIDTH),
        "w_branch_b": w(ks[12], (DEPTH, B_WIDTH, D_MODEL), B_WIDTH),
        "w_out": w(ks[13], (DEPTH, D_MODEL, D_MODEL), D_MODEL),
        "ffn_norm": g(ks[14], (DEPTH, D_MODEL)),
        "dense_w_gate_up": w(ks[15], (N_DENSE, D_MODEL, 2 * D_FF), D_MODEL),
        "dense_w_down": w(ks[16], (N_DENSE, D_FF, D_MODEL), D_FF),
        "router_w": w(ks[17], (N_MOE, D_MODEL, N_EXPERTS), D_MODEL),
        "expert_w_gate_up": w(ks[18], (N_MOE, N_EXPERTS, D_MODEL, 2 * D_FF), D_MODEL),
        "expert_w_down": w(ks[19], (N_MOE, N_EXPERTS, D_FF, D_MODEL), D_FF),
    }


def reference(x, attn_norm, w_in, moba_q_norm, moba_k_norm, mla_cq_norm, w_uq, mla_ckv_norm,
              w_ukv, mla_q_norm, mla_k_norm, w_branch_a, w_branch_b, w_out, ffn_norm,
              dense_w_gate_up, dense_w_down, router_w, expert_w_gate_up, expert_w_down):
    for l in range(DEPTH):
        x = x + token_mixer(x, attn_norm[l], w_in[l], moba_q_norm[l], moba_k_norm[l],
                            mla_cq_norm[l], w_uq[l], mla_ckv_norm[l], w_ukv[l],
                            mla_q_norm[l], mla_k_norm[l], w_branch_a[l], w_branch_b[l], w_out[l])
        h = rms_norm(x, ffn_norm[l])
        if l % 2 == 0:
            x = x + swiglu(h, dense_w_gate_up[l // 2], dense_w_down[l // 2])
        else:
            x = x + moe_swiglu(h, router_w[l // 2], expert_w_gate_up[l // 2], expert_w_down[l // 2])
    return x
```

```cpp
#include <hip/hip_runtime.h>
#include <hip/hip_bf16.h>
#include <cstdio>
#include <cstdint>

#ifndef MK_SPLIT
#define MK_SPLIT 0
#endif

constexpr int BATCH = 8, SEQ = 4096, D = 1024, M = BATCH * SEQ;
constexpr int AW = 512;
constexpr int QRANK = 384, KVRANK = 256;
constexpr int INW = 4256, INWP = 4352;
constexpr int LATW = 768;
constexpr int DFF = 2816, NEXP = 8;
constexpr int MOE_TILES_MAX = 264;
constexpr float EPS = 1e-6f;
constexpr float LOG2E = 1.4426950408889634f;
constexpr float C2A = 0.125f * LOG2E;
constexpr float C2B = 0.10206207261596575f * LOG2E;

constexpr size_t MiB = 1u << 20;
constexpr size_t WS_CTL = 0, CTL_ZERO_BYTES = 1 * MiB;
constexpr size_t WS_KMEAN = 1 * MiB;
constexpr size_t WS_ROPE = 1 * MiB + 512 * 1024;
constexpr size_t WS_ELIST = 3 * MiB;
constexpr size_t WS_TOKP = 4 * MiB;
constexpr size_t WS_WCNT = 4 * MiB + 512 * 1024;
constexpr size_t WS_TAILSLOT = 12 * MiB;
constexpr size_t WS_KPART = 16 * MiB;
constexpr size_t WS_SSLAT = 5 * MiB;
constexpr size_t WS_KMP = 8 * MiB;
constexpr size_t WS_WL = 16 * MiB, WL_STRIDE = 14 * MiB;
constexpr size_t WL_IN = 0, WL_UQ = WL_IN + (size_t)INWP * D * 2, WL_UKV = WL_UQ + (size_t)768 * QRANK * 2, WL_BRA = WL_UKV + (size_t)1024 * KVRANK * 2,
                 WL_BRB = WL_BRA + (size_t)D * AW * 2, WL_OUT = WL_BRB + (size_t)D * AW * 2, WL_END = WL_OUT + (size_t)D * D * 2;
static_assert(WL_END <= WL_STRIDE, "per-layer weights");
constexpr size_t WS_WGU = 44 * MiB, WS_WDN = 55 * MiB;
constexpr size_t WS_XB = 64 * MiB;
constexpr size_t WS_QA = 128 * MiB, WS_KA = 160 * MiB, WS_VA = 192 * MiB;
constexpr size_t WS_LAT = 224 * MiB, WS_GATES = 272 * MiB, WS_QB = 400 * MiB, WS_KVR = 448 * MiB, WS_KB = 512 * MiB, WS_YB = 560 * MiB, WS_YA = 592 * MiB;
constexpr size_t WS_ACT0 = 128 * MiB;
constexpr size_t WS_Y = 128 * MiB;
constexpr size_t WS_WEGU = 192 * MiB, WS_WEDN = 280 * MiB;
constexpr size_t WS_ACT1 = 324 * MiB;
constexpr size_t WS_END = 688 * MiB;
static_assert(WS_ACT1 + (size_t)MOE_TILES_MAX * 256 * DFF * 2 <= WS_END, "ws map");

constexpr int CW_TMO = 0, CW_BAR = 4096, CW_QUEUE = 8192  , CW_ECNT = 10240;

constexpr int RING_BYTES = 131072, LDSCTL_OFF = RING_BYTES, MISC_OFF = LDSCTL_OFF + 320, LDS_BYTES = 147456;

#define GAS __attribute__((address_space(1)))
#define LAS __attribute__((address_space(3)))
typedef unsigned short bf16;
typedef unsigned v4u __attribute__((ext_vector_type(4)));
typedef unsigned v2u __attribute__((ext_vector_type(2)));
typedef float f32x4 __attribute__((ext_vector_type(4)));
typedef float f32x16 __attribute__((ext_vector_type(16)));
typedef short bf16x8 __attribute__((ext_vector_type(8)));
typedef short s16x4 __attribute__((ext_vector_type(4)));
typedef GAS unsigned gu32;
typedef GAS unsigned char* gws_t;
typedef GAS unsigned short* gbf;
typedef const GAS unsigned short* gcbf;
typedef GAS float* gf32;
typedef const GAS float* gcf32;
#define RLX_AGENT __ATOMIC_RELAXED, __HIP_MEMORY_SCOPE_AGENT
#define LDS_WAIT() asm volatile("s_waitcnt lgkmcnt(0)" ::: "memory")
#define VM_WAIT() asm volatile("s_waitcnt vmcnt(0)" ::: "memory")

__device__ __forceinline__ unsigned cvt_pk_bf16(float lo, float hi) { unsigned r; asm volatile("v_cvt_pk_bf16_f32 %0, %1, %2" : "=v"(r) : "v"(lo), "v"(hi)); return r; }
__device__ __forceinline__ float bf_lo(unsigned w) { return __uint_as_float(w << 16); }
__device__ __forceinline__ float bf_hi(unsigned w) { return __uint_as_float(w & 0xffff0000u); }
__device__ __forceinline__ int fresh_lane() { unsigned z = 0u; asm volatile("" : "+v"(z)); return (int)__builtin_amdgcn_mbcnt_hi(~0u, __builtin_amdgcn_mbcnt_lo(~0u, z)); }
__device__ __forceinline__ int phase_tid(int wave0) { unsigned z = 0u; asm volatile("" : "+v"(z)); return wave0 * 64 + (int)__builtin_amdgcn_mbcnt_hi(~0u, __builtin_amdgcn_mbcnt_lo(~0u, z)); }
__device__ __forceinline__ float xshfl(float v, int m, int lane) { return __int_as_float(__builtin_amdgcn_ds_bpermute((lane ^ m) << 2, __float_as_int(v))); }
__device__ __forceinline__ float wave_sum(float v, int lane) {
#pragma unroll
    for (int o = 1; o < 64; o <<= 1) v += xshfl(v, o, lane);
    return v;
}
__device__ __forceinline__ float fast_sigmoid(float x) { return __builtin_amdgcn_rcpf(1.0f + __builtin_amdgcn_exp2f(-x * LOG2E)); }

namespace pg8 {
#define PG8_LAS __attribute__((address_space(3)))
typedef unsigned short bf16_t;
constexpr int BM = 256, BK = 64, HALF = 128, HTB = HALF * BK * 2, STAGE_BYTES = 8 * HTB, NXCD = 8, WGM = 8;
__host__ __device__ __forceinline__ int lds_byte(int r, int c) { const int st = (r >> 4) * 2 + (c >> 5), rr = r & 15, cc = c & 31, ob = rr * 64 + cc * 2; return st * 1024 + (ob ^ (((ob >> 9) & 1) << 5)); }
__host__ __device__ __forceinline__ void stage_rc(int b, int& R, int& C) { const int st = b / 1024, sb = b % 1024, swz = sb ^ (((sb >> 9) & 1) << 5); R = (st >> 1) * 16 + swz / 64; C = (st & 1) * 32 + (swz % 64) / 2; }
__host__ __device__ __forceinline__ int perm32(int rho) { const int n = rho >> 4, i = rho & 15; return 8 * (i >> 2) + 4 * n + (i & 3); }

struct Unit { int pm, pn, e, part; };

struct OrderBase {
    int nM, nN, nwg, G, c;
    __device__ __forceinline__ void init_tiles(int nM_, int nN_, int G_, int c_) { nM = nM_; nN = nN_; nwg = nM * nN; G = G_; c = c_; }
    __device__ __forceinline__ bool next_tile(int i, Unit& u) const {
        const long L = (long)i * G + c; if (L >= nwg) return false;
        tile_of((int)L, u); return true;
    }
    __device__ __forceinline__ void tile_of(int L, Unit& u) const {
        int wgid = L; { const int q = nwg / NXCD, r = nwg % NXCD, xcd = wgid % NXCD, off = wgid / NXCD; wgid = (xcd < r ? xcd * (q + 1) : r * (q + 1) + (xcd - r) * q) + off; }
        const int nig = WGM * nN, gid = wgid / nig, fm = gid * WGM, gsz = (nM - fm) < WGM ? (nM - fm) : WGM;
        u.pm = fm + ((wgid % nig) % gsz); u.pn = (wgid % nig) / gsz; u.e = 0;
    }
};
struct SchedDense : OrderBase {
    static constexpr bool EARLY_ROWS = false, KSPLIT = false;
    __device__ __forceinline__ bool next(int i, Unit& u) const { return next_tile(i, u); }
    __device__ __forceinline__ int arow(const Unit& u, int r) const { return u.pm * BM + r; }
};
struct SchedBranch : OrderBase {
    static constexpr bool EARLY_ROWS = false, KSPLIT = false;
    __device__ __forceinline__ bool next(int i, Unit& u) const { if (!next_tile(i >> 1, u)) return false; u.e = i & 1; return true; }
    __device__ __forceinline__ int arow(const Unit& u, int r) const { return u.pm * BM + r + (u.e == 0 ? 32768 : 0); }
};
struct SchedMoe : OrderBase {
    static constexpr bool EARLY_ROWS = true, KSPLIT = false;
    const volatile PG8_LAS int* tab; const GAS int* list; int gather;
    __device__ __forceinline__ bool next(int i, Unit& u) const {
        if (!next_tile(i, u)) return false;
        int e = 0;
#pragma unroll
        for (int k = 1; k < 8; ++k) e += (u.pm >= tab[k]) ? 1 : 0;
        u.e = __builtin_amdgcn_readfirstlane(e); return true;
    }
    __device__ __forceinline__ int arow(const Unit& u, int r) const {
        if (!gather) return u.pm * BM + r;
        const int pos = (u.pm - tab[u.e]) * BM + r;
        return pos < tab[16 + u.e] ? (list[u.e * 32768 + pos] >> 1) : 0;
    }
};

constexpr int KPARTS = 11, KPART_TILES = 4;
struct SchedMoeK : OrderBase {
    static constexpr bool EARLY_ROWS = true, KSPLIT = true;
    const volatile PG8_LAS int* tab; int RG, TS;
    __device__ __forceinline__ void init_split() { const int R = nwg / G, T = nwg - R * G; if (T > 0 && T * KPARTS <= G) { RG = R * G; TS = T * KPARTS; } else { RG = nwg; TS = 0; } }
    __device__ __forceinline__ bool next(int i, Unit& u) const {
        const int L = i * G + c;
        if (L < RG) { tile_of(L, u); u.part = -1; }
        else { const int idx = L - RG; if (idx >= TS) return false; tile_of(RG + idx / KPARTS, u); u.part = idx; }
        int e = 0;
#pragma unroll
        for (int k = 1; k < 8; ++k) e += (u.pm >= tab[k]) ? 1 : 0;
        u.e = __builtin_amdgcn_readfirstlane(e); return true;
    }
    static __device__ __forceinline__ int k0(const Unit& u) { return u.part < 0 ? 0 : (u.part % KPARTS) * KPART_TILES; }
    __device__ __forceinline__ int arow(const Unit& u, int r) const { return u.pm * BM + r; }
};

template <class Sched> __device__ __forceinline__ unsigned pg8_koff(const Unit& u) { if constexpr (Sched::KSPLIT) return (unsigned)Sched::k0(u) * (unsigned)(BK * 2); else return 0u; }
template <class Epi, class Sched, bool ALIGN_EPI>
__device__ __forceinline__ void gemm_phase(int wave0, PG8_LAS unsigned char* lds, gcbf Ag, int lda, gcbf Bg, int ldb, int browsE, int K, const Sched& S, const Epi& E) {
    const int tid = phase_tid(wave0);
    const int wid = __builtin_amdgcn_readfirstlane(tid >> 6), lane = tid & 63, wr = wid >> 2, wc = wid & 3, fr = lane & 15, fq = lane >> 4;
    const int nt = K / BK;
#define PG8_KOFF(unit) pg8_koff<Sched>(unit)
    unsigned voffB[2];
#pragma unroll
    for (int i = 0; i < 2; ++i) { int R, C; stage_rc(tid * 16 + i * 8192, R, C); const int Rb = Epi::PERM ? ((R & ~31) + perm32(R & 31)) : R;
        voffB[i] = (unsigned)(Rb * ldb + C) * 2u; }
#define PG8_AOFFS(dst, unit) do { int t_ = tid; asm volatile("" : "+v"(t_)); _Pragma("unroll") for (int i = 0; i < 2; ++i) { int R, C; stage_rc(t_ * 16 + i * 8192, R, C); \
        _Pragma("unroll") for (int h = 0; h < 2; ++h) dst[h][i] = (unsigned)S.arow(unit, h * HALF + R) * lda2 + (unsigned)C * 2u + PG8_KOFF(unit); } } while (0)
#define PG8_AROWS(dst, unit) do { int t_ = tid; asm volatile("" : "+v"(t_)); _Pragma("unroll") for (int i = 0; i < 2; ++i) { int R, C; stage_rc(t_ * 16 + i * 8192, R, C); \
        _Pragma("unroll") for (int h = 0; h < 2; ++h) dst[h][i] = S.arow(unit, h * HALF + R); } } while (0)
#define PG8_AOFFS_R(dst, rows, unit) do { int t_ = tid; asm volatile("" : "+v"(t_)); _Pragma("unroll") for (int i = 0; i < 2; ++i) { int R, C; stage_rc(t_ * 16 + i * 8192, R, C); \
        _Pragma("unroll") for (int h = 0; h < 2; ++h) dst[h][i] = (unsigned)rows[h][i] * lda2 + (unsigned)C * 2u + PG8_KOFF(unit); } } while (0)
    const size_t kstep = (size_t)(BK * 2);
    const size_t hstepB = (size_t)HALF * ldb * 2;
    const unsigned lda2 = (unsigned)lda * 2u;
    const unsigned ldsw = (unsigned)wid * 1024u;
    const int aoff = lds_byte(wr * 64 + fr, fq * 8), boff = lds_byte(wc * 32 + fr, fq * 8);
    const GAS char* Abase = (const GAS char*)Ag;
#define PG8_SA(b, h) (((b) * 2 + (h)) * HTB)
#define PG8_SB(b, h) ((4 + (b) * 2 + (h)) * HTB)
#define PG8_STAGEB(bufoff, gbase) do { _Pragma("unroll") for (int _i = 0; _i < 2; ++_i) \
        __builtin_amdgcn_global_load_lds((const GAS unsigned*)((gbase) + voffB[_i]), (PG8_LAS unsigned*)(lds + (bufoff) + ldsw + _i * 8192), 16, 0, 0); } while (0)
#define PG8_STAGEA(bufoff, kb, VO, h) do { _Pragma("unroll") for (int _i = 0; _i < 2; ++_i) \
        __builtin_amdgcn_global_load_lds((const GAS unsigned*)(Abase + (kb) + (VO)[h][_i]), (PG8_LAS unsigned*)(lds + (bufoff) + ldsw + _i * 8192), 16, 0, 0); } while (0)
#define PG8_LDA(dst, b, h) do { _Pragma("unroll") for (int m = 0; m < 4; ++m) _Pragma("unroll") for (int k = 0; k < 2; ++k) dst[m][k] = *(const PG8_LAS bf16x8*)(lds + PG8_SA(b, h) + aoff + m * 2048 + k * 1024); } while (0)
#define PG8_LDB(dst, b, h) do { _Pragma("unroll") for (int n = 0; n < 2; ++n) _Pragma("unroll") for (int k = 0; k < 2; ++k) dst[n][k] = *(const PG8_LAS bf16x8*)(lds + PG8_SB(b, h) + boff + n * 2048 + k * 1024); } while (0)
#define PG8_MMA(ai, bj, At, Bt) do { __builtin_amdgcn_s_setprio(1); _Pragma("unroll") for (int m = 0; m < 4; ++m) _Pragma("unroll") for (int n = 0; n < 2; ++n) _Pragma("unroll") for (int k = 0; k < 2; ++k) \
        acc[ai][bj][m][n] = __builtin_amdgcn_mfma_f32_16x16x32_bf16(Bt[n][k], At[m][k], acc[ai][bj][m][n], 0, 0, 0); __builtin_amdgcn_s_setprio(0); } while (0)
#define PG8_WAIT_V(n) asm volatile("s_waitcnt vmcnt(" #n ")" ::: "memory")
#define PG8_WAIT_L(n) asm volatile("s_waitcnt lgkmcnt(" #n ")" ::: "memory")
#define PG8_BAR __builtin_amdgcn_s_barrier()
#define PG8_SCHED __builtin_amdgcn_sched_barrier(0)
    Unit cur, nxt; int ui = 0;
    if (!S.next(0, cur)) return;
    PG8_LAS unsigned* const stash0 = (PG8_LAS unsigned*)(lds + STAGE_BYTES + 1024);
    E.stash(cur, tid, stash0);
    f32x4 acc[2][2][4][2];
#pragma unroll
    for (int a = 0; a < 2; ++a)
#pragma unroll
        for (int b = 0; b < 2; ++b)
#pragma unroll
            for (int m = 0; m < 4; ++m)
#pragma unroll
                for (int n = 0; n < 2; ++n) acc[a][b][m][n] = (f32x4){0.f, 0.f, 0.f, 0.f};
    bf16x8 At[4][2], B0[2][2], B1[2][2];
    unsigned vA[2][2];
    PG8_AOFFS(vA, cur);
    const GAS char* cB = (const GAS char*)Bg + ((size_t)cur.e * browsE + (size_t)cur.pn * BM) * ldb * 2 + PG8_KOFF(cur);
    PG8_STAGEB(PG8_SB(0, 0), cB); PG8_STAGEB(PG8_SB(0, 1), cB + hstepB); PG8_STAGEA(PG8_SA(0, 0), 0, vA, 0); PG8_STAGEA(PG8_SA(0, 1), 0, vA, 1);
    if (wr == 1) PG8_BAR;
    PG8_WAIT_V(2); PG8_BAR;
    PG8_STAGEB(PG8_SB(1, 0), cB + kstep); PG8_STAGEA(PG8_SA(1, 0), kstep, vA, 0); PG8_STAGEB(PG8_SB(1, 1), cB + hstepB + kstep);
    PG8_WAIT_V(6); PG8_BAR;
    for (;;) {
        const bool has_next = S.next(ui + 1, nxt);
        if (!has_next) nxt = cur;
        int nrows[2][2];
        if constexpr (Sched::EARLY_ROWS) { PG8_AROWS(nrows, nxt); }
        const GAS char* nB = (const GAS char*)Bg + ((size_t)nxt.e * browsE + (size_t)nxt.pn * BM) * ldb * 2 + PG8_KOFF(nxt);
        int unt = nt; if constexpr (Sched::KSPLIT) unt = (cur.part < 0) ? nt : KPART_TILES;
        for (int t = 0; t < unt; t += 2) {
            const bool last = (t == unt - 2);
            const size_t ka1 = (size_t)(t + 1) * kstep;
            const size_t ka2 = last ? (size_t)0 : (size_t)(t + 2) * kstep; const GAS char* b2 = last ? nB : cB + (size_t)(t + 2) * kstep;
            const size_t ka3 = ka2 + kstep; const GAS char* b3 = b2 + kstep;
            unsigned sA[2][2];
            if (last) { if constexpr (Sched::EARLY_ROWS) { PG8_AOFFS_R(sA, nrows, nxt); } else { PG8_AOFFS(sA, nxt); } }
            else {
#pragma unroll
                for (int h = 0; h < 2; ++h)
#pragma unroll
                    for (int i = 0; i < 2; ++i) sA[h][i] = vA[h][i]; }
            PG8_LDB(B0, 0, 0); PG8_LDB(B1, 0, 1); PG8_SCHED; PG8_LDA(At, 0, 0); PG8_STAGEA(PG8_SA(1, 1), ka1, vA, 1);
            PG8_WAIT_V(8); PG8_WAIT_L(0); PG8_BAR; PG8_MMA(0, 0, At, B0); PG8_MMA(0, 1, At, B1); PG8_BAR; PG8_SCHED;
            PG8_LDA(At, 0, 1); PG8_STAGEB(PG8_SB(0, 0), b2); PG8_STAGEB(PG8_SB(0, 1), b2 + hstepB); PG8_STAGEA(PG8_SA(0, 0), ka2, sA, 0);
            PG8_WAIT_V(8); PG8_WAIT_L(0); PG8_BAR; PG8_MMA(1, 0, At, B0); PG8_MMA(1, 1, At, B1); PG8_BAR; PG8_SCHED;
            PG8_LDB(B0, 1, 0); PG8_LDB(B1, 1, 1); PG8_SCHED; PG8_LDA(At, 1, 0); PG8_STAGEA(PG8_SA(0, 1), ka2, sA, 1);
            PG8_WAIT_V(8); PG8_WAIT_L(0); PG8_BAR; PG8_MMA(0, 0, At, B0); PG8_MMA(0, 1, At, B1); PG8_BAR; PG8_SCHED;
            PG8_LDA(At, 1, 1); PG8_STAGEB(PG8_SB(1, 0), b3); PG8_STAGEB(PG8_SB(1, 1), b3 + hstepB); PG8_STAGEA(PG8_SA(1, 0), ka3, sA, 0);
            PG8_WAIT_V(8); PG8_WAIT_L(0); PG8_BAR; PG8_MMA(1, 0, At, B0); PG8_MMA(1, 1, At, B1); PG8_BAR; PG8_SCHED;
        }
        if constexpr (ALIGN_EPI) { if (wr == 0) PG8_BAR; }
        E(acc, cur, wr, wc, stash0 + (ui & 1) * 1024);
        if (!has_next) break;
        if (!Epi::chained(cur)) {
#pragma unroll
        for (int a = 0; a < 2; ++a)
#pragma unroll
            for (int b = 0; b < 2; ++b)
#pragma unroll
                for (int m = 0; m < 4; ++m)
#pragma unroll
                    for (int n = 0; n < 2; ++n) acc[a][b][m][n] = (f32x4){0.f, 0.f, 0.f, 0.f};
        }
        cur = nxt; cB = nB; ++ui;
        E.stash(cur, phase_tid(wave0), stash0 + (ui & 1) * 1024);
        if constexpr (Sched::EARLY_ROWS) { PG8_AOFFS_R(vA, nrows, cur); } else { PG8_AOFFS(vA, cur); }
        if constexpr (ALIGN_EPI) { if (wr == 1) PG8_BAR; }
    }
    PG8_WAIT_V(0);
    if constexpr (!ALIGN_EPI) { if (wr == 0) PG8_BAR; }
    PG8_BAR;
#undef PG8_SA
#undef PG8_SB
#undef PG8_STAGEA
#undef PG8_AOFFS
#undef PG8_AROWS
#undef PG8_AOFFS_R
#undef PG8_KOFF
#undef PG8_STAGEB
#undef PG8_LDA
#undef PG8_LDB
#undef PG8_MMA
#undef PG8_WAIT_V
#undef PG8_WAIT_L
#undef PG8_BAR
#undef PG8_SCHED
}

typedef f32x4 Acc[2][2][4][2];

struct EpiInProj {
    static constexpr bool PERM = true; static __device__ __forceinline__ bool chained(const Unit&) { return false; } __device__ __forceinline__ void stash(const Unit&, int, PG8_LAS unsigned*) const {}
    gws_t ws; gcf32 gq, gk;
    __device__ __forceinline__ void operator()(Acc& acc, const Unit& u, int wr, int wc, const PG8_LAS unsigned* st) const {
        const int ln_ = fresh_lane(), fr = ln_ & 15, fq = ln_ >> 4;
        const int lane = fq * 16 + fr;
        if (u.pn < 4) {
            const bool isK = u.pn >= 2; const int head = 4 * (u.pn & 1) + wc;
            gcf32 gp = isK ? gk : gq; gbf base = (gbf)(ws + (isK ? WS_KA : WS_QA)); gcf32 ct = (gcf32)(ws + WS_ROPE), st = ct + 4096 * 8;
            f32x4 g[2][2];
#pragma unroll
            for (int bj = 0; bj < 2; ++bj)
#pragma unroll
                for (int n = 0; n < 2; ++n) g[bj][n] = *(const GAS f32x4*)(gp + 8 * (2 * fq + bj) + 4 * n);
            f32x4 ks[2][2];
#pragma unroll
            for (int bj = 0; bj < 2; ++bj)
#pragma unroll
                for (int n = 0; n < 2; ++n) ks[bj][n] = (f32x4){0.f, 0.f, 0.f, 0.f};
            const int row0 = u.pm * BM + wr * 64 + fr;
#pragma unroll
            for (int ai = 0; ai < 2; ++ai)
#pragma unroll
                for (int m = 0; m < 4; ++m) { const int row = row0 + ai * HALF + m * 16, pos = row & (SEQ - 1);
                    f32x4 y[2][2]; float ss = 0.f;
#pragma unroll
                    for (int bj = 0; bj < 2; ++bj)
#pragma unroll
                        for (int n = 0; n < 2; ++n) { y[bj][n] = acc[ai][bj][m][n]; ss += (y[bj][n][0] * y[bj][n][0] + y[bj][n][1] * y[bj][n][1]) + (y[bj][n][2] * y[bj][n][2] + y[bj][n][3] * y[bj][n][3]); }
                    ss += xshfl(ss, 16, lane); ss += xshfl(ss, 32, lane);
                    const float rstd = 1.0f / sqrtf(ss * (1.f / 64.f) + EPS);
#pragma unroll
                    for (int bj = 0; bj < 2; ++bj)
#pragma unroll
                        for (int n = 0; n < 2; ++n) y[bj][n] = y[bj][n] * rstd * g[bj][n];
                    if (fq == 0) {
#pragma unroll
                        for (int n = 0; n < 2; ++n) { const f32x4 c = *(const GAS f32x4*)(ct + pos * 8 + 4 * n), s = *(const GAS f32x4*)(st + pos * 8 + 4 * n);
                            const f32x4 x1 = y[0][n], x2 = y[1][n]; y[0][n] = x1 * c - x2 * s; y[1][n] = x2 * c + x1 * s; } }
                    if (isK) {
#pragma unroll
                        for (int bj = 0; bj < 2; ++bj)
#pragma unroll
                            for (int n = 0; n < 2; ++n) ks[bj][n] += y[bj][n];
                    } else {
#pragma unroll
                        for (int bj = 0; bj < 2; ++bj)
#pragma unroll
                            for (int n = 0; n < 2; ++n) y[bj][n] = y[bj][n] * C2A;
                    }
                    gbf rowp = base + (size_t)row * AW + head * 64;
#pragma unroll
                    for (int bj = 0; bj < 2; ++bj) { v4u w; w.x = cvt_pk_bf16(y[bj][0][0], y[bj][0][1]); w.y = cvt_pk_bf16(y[bj][0][2], y[bj][0][3]); w.z = cvt_pk_bf16(y[bj][1][0], y[bj][1][1]); w.w = cvt_pk_bf16(y[bj][1][2], y[bj][1][3]);
                        *(GAS v4u*)(rowp + 8 * (2 * fq + bj)) = w; } }
            if (isK) {
#pragma unroll
                for (int bj = 0; bj < 2; ++bj)
#pragma unroll
                    for (int n = 0; n < 2; ++n)
#pragma unroll
                        for (int e = 0; e < 4; ++e) { float v = ks[bj][n][e]; v += xshfl(v, 1, lane); v += xshfl(v, 2, lane); v += xshfl(v, 4, lane); v += xshfl(v, 8, lane); ks[bj][n][e] = v; }
                if (fr == 0) { gf32 kp = (gf32)(ws + WS_KMP) + ((size_t)(u.pm * 2 + wr) * 8 + head) * 64;
#pragma unroll
                    for (int bj = 0; bj < 2; ++bj)
#pragma unroll
                        for (int n = 0; n < 2; ++n) *(GAS f32x4*)(kp + 8 * (2 * fq + bj) + 4 * n) = ks[bj][n]; }
            }
            return;
        }
        size_t boff; int ld, colt; bool sig = false;
        if (u.pn < 6) { boff = WS_VA; ld = AW; colt = (u.pn & 1) * 256; }
        else if (u.pn < 9) { boff = WS_LAT; ld = LATW; colt = (u.pn - 6) * 256; }
        else { boff = WS_GATES; ld = 2048; colt = (u.pn - 9) * 256; sig = true; }
        gbf base = (gbf)(ws + boff);
        const bool lat = (u.pn >= 6 && u.pn < 9);
        const int row0 = u.pm * BM + wr * 64 + fr, col0 = colt + wc * 32 + 8 * fq;
        if (sig) {
            GAS unsigned char* gb = (GAS unsigned char*)(ws + WS_GATES);
#pragma unroll
            for (int ai = 0; ai < 2; ++ai)
#pragma unroll
                for (int m = 0; m < 4; ++m) { const int row = row0 + ai * HALF + m * 16; unsigned q[4];
#pragma unroll
                    for (int bj = 0; bj < 2; ++bj)
#pragma unroll
                        for (int n = 0; n < 2; ++n) { const f32x4 v = acc[ai][bj][m][n]; unsigned w = 0u;
#pragma unroll
                            for (int e = 0; e < 4; ++e) w |= (unsigned)fminf(fast_sigmoid(v[e]) * 256.f, 255.f) << (8 * e);
                            q[2 * bj + n] = w; }
                    *(GAS v4u*)(gb + (size_t)row * 2048 + colt + wc * 64 + fq * 16) = (v4u){q[0], q[1], q[2], q[3]}; }
            return;
        }
#pragma unroll
        for (int ai = 0; ai < 2; ++ai)
#pragma unroll
            for (int m = 0; m < 4; ++m) { const int row = row0 + ai * HALF + m * 16; gbf rowp = base + (size_t)row * ld + col0;
#pragma unroll
                for (int bj = 0; bj < 2; ++bj) { f32x4 v0 = acc[ai][bj][m][0], v1 = acc[ai][bj][m][1];
                    if (lat) { float ss = (v0[0] * v0[0] + v0[1] * v0[1]) + (v0[2] * v0[2] + v0[3] * v0[3]) + (v1[0] * v1[0] + v1[1] * v1[1]) + (v1[2] * v1[2] + v1[3] * v1[3]);
                        ss += xshfl(ss, 16, lane); ss += xshfl(ss, 32, lane);
                        if (fq == 0) ((gf32)(ws + WS_SSLAT))[(size_t)row * 24 + (u.pn - 6) * 8 + bj * 4 + wc] = ss; }
                    v4u w; w.x = cvt_pk_bf16(v0[0], v0[1]); w.y = cvt_pk_bf16(v0[2], v0[3]); w.z = cvt_pk_bf16(v1[0], v1[1]); w.w = cvt_pk_bf16(v1[2], v1[3]);
                    *(GAS v4u*)(rowp + bj * HALF) = w; } }
    }
};
struct EpiUq {
    static constexpr bool PERM = true; static __device__ __forceinline__ bool chained(const Unit&) { return false; }
    gws_t ws;
    __device__ __forceinline__ void stash(const Unit& u, int tid, PG8_LAS unsigned* st) const {
        if (tid < BM) { gcf32 sp = (gcf32)(ws + WS_SSLAT) + (size_t)(u.pm * BM + tid) * 24;
            const f32x4 a = *(const GAS f32x4*)sp, b = *(const GAS f32x4*)(sp + 4), c = *(const GAS f32x4*)(sp + 8);
            const float ss = ((a[0] + a[1]) + (a[2] + a[3])) + ((b[0] + b[1]) + (b[2] + b[3])) + ((c[0] + c[1]) + (c[2] + c[3]));
            st[tid] = __float_as_uint(1.0f / sqrtf(ss * (1.f / QRANK) + EPS)); }
    }
    __device__ __forceinline__ void operator()(Acc& acc, const Unit& u, int wr, int wc, const PG8_LAS unsigned* st) const {
        const int ln_ = fresh_lane(), fr = ln_ & 15, fq = ln_ >> 4;
        gbf O = (gbf)(ws + WS_QB);
        const int r0 = wr * 64 + fr, col0 = u.pn * BM + wc * 32 + 8 * fq;
#pragma unroll
        for (int ai = 0; ai < 2; ++ai)
#pragma unroll
            for (int m = 0; m < 4; ++m) { const int r = r0 + ai * HALF + m * 16; const float rstd = __uint_as_float(st[r]);
                gbf rowp = O + (size_t)(u.pm * BM + r) * 768 + col0;
#pragma unroll
                for (int bj = 0; bj < 2; ++bj) { const f32x4 v0 = acc[ai][bj][m][0] * rstd, v1 = acc[ai][bj][m][1] * rstd;
                    v4u w; w.x = cvt_pk_bf16(v0[0], v0[1]); w.y = cvt_pk_bf16(v0[2], v0[3]); w.z = cvt_pk_bf16(v1[0], v1[1]); w.w = cvt_pk_bf16(v1[2], v1[3]);
                    *(GAS v4u*)(rowp + bj * HALF) = w; } }
    }
};
struct EpiUkvK {
    static constexpr bool PERM = true; static __device__ __forceinline__ bool chained(const Unit&) { return false; }
    gws_t ws; gcf32 gk;
    __device__ __forceinline__ void stash(const Unit& u, int tid, PG8_LAS unsigned* st) const {
        if (tid < BM) { gcf32 sp = (gcf32)(ws + WS_SSLAT) + (size_t)(u.pm * BM + tid) * 24;
            const f32x4 a = *(const GAS f32x4*)(sp + 12), b = *(const GAS f32x4*)(sp + 16);
            st[2 * tid] = __float_as_uint(1.0f / sqrtf((((a[0] + a[1]) + (a[2] + a[3])) + ((b[0] + b[1]) + (b[2] + b[3]))) * (1.f / KVRANK) + EPS)); st[2 * tid + 1] = __float_as_uint(sp[20]); }
    }
    __device__ __forceinline__ void operator()(Acc& acc, const Unit& u, int wr, int wc, const PG8_LAS unsigned* st) const {
        const int ln_ = fresh_lane(), fr = ln_ & 15, fq = ln_ >> 4;
        const int lane = fq * 16 + fr; gcf32 SS = (gcf32)(ws + WS_SSLAT);
        const int row0 = u.pm * BM + wr * 64 + fr;
        {
            const int head = 4 * u.pn + wc; gbf KBp = (gbf)(ws + WS_KB);
            float rhs[8];
            {
                f32x4 g[2][2];
#pragma unroll
                for (int bj = 0; bj < 2; ++bj)
#pragma unroll
                    for (int n = 0; n < 2; ++n) g[bj][n] = *(const GAS f32x4*)(gk + 32 * bj + 8 * fq + 4 * n);
#pragma unroll
                for (int ai = 0; ai < 2; ++ai)
#pragma unroll
                    for (int m = 0; m < 4; ++m) { const int row = row0 + ai * HALF + m * 16; const int rl = wr * 64 + fr + ai * HALF + m * 16;
                        const float rc = __uint_as_float(st[2 * rl]), sskr = __uint_as_float(st[2 * rl + 1]);
                        f32x4 y[2][2]; float ss = 0.f;
#pragma unroll
                        for (int bj = 0; bj < 2; ++bj)
#pragma unroll
                            for (int n = 0; n < 2; ++n) { y[bj][n] = acc[ai][bj][m][n] * rc; ss += (y[bj][n][0] * y[bj][n][0] + y[bj][n][1] * y[bj][n][1]) + (y[bj][n][2] * y[bj][n][2] + y[bj][n][3] * y[bj][n][3]); }
                        ss += xshfl(ss, 16, lane); ss += xshfl(ss, 32, lane);
                        const float rh = 1.0f / sqrtf((ss + sskr) * (1.f / 96.f) + EPS);
                        rhs[ai * 4 + m] = rh;
                        gbf rowp = KBp + (size_t)row * 768 + head * 96;
#pragma unroll
                        for (int bj = 0; bj < 2; ++bj) { const f32x4 v0 = y[bj][0] * rh * g[bj][0], v1 = y[bj][1] * rh * g[bj][1];
                            v4u w; w.x = cvt_pk_bf16(v0[0], v0[1]); w.y = cvt_pk_bf16(v0[2], v0[3]); w.z = cvt_pk_bf16(v1[0], v1[1]); w.w = cvt_pk_bf16(v1[2], v1[3]);
                            *(GAS v4u*)(rowp + 32 * bj + 8 * fq) = w; }
                        asm volatile("" ::: "memory"); }
            }
            {
                gcbf LATp = (gcbf)(ws + WS_LAT); gcf32 ct = (gcf32)(ws + WS_ROPE) + 2 * 4096 * 8, st = ct + 4096 * 16;
                const int ro = 8 * fq, rp = (8 * fq + 16) & 31, ci = (8 * fq) & 15;
                const f32x4 go0 = *(const GAS f32x4*)(gk + 64 + ro), go1 = *(const GAS f32x4*)(gk + 64 + ro + 4), gp0 = *(const GAS f32x4*)(gk + 64 + rp), gp1 = *(const GAS f32x4*)(gk + 64 + rp + 4);
#pragma unroll
                for (int ai = 0; ai < 2; ++ai)
#pragma unroll
                    for (int m = 0; m < 4; ++m) { const int row = row0 + ai * HALF + m * 16, pos = row & (SEQ - 1); const float rh = rhs[ai * 4 + m];
                        const v4u wo = *(const GAS v4u*)(LATp + (size_t)row * LATW + 640 + ro), wp = *(const GAS v4u*)(LATp + (size_t)row * LATW + 640 + rp);
                        const f32x4 c0 = *(const GAS f32x4*)(ct + pos * 16 + ci), c1 = *(const GAS f32x4*)(ct + pos * 16 + ci + 4), s0 = *(const GAS f32x4*)(st + pos * 16 + ci), s1 = *(const GAS f32x4*)(st + pos * 16 + ci + 4);
                        const f32x4 xo0 = (f32x4){bf_lo(wo.x), bf_hi(wo.x), bf_lo(wo.y), bf_hi(wo.y)} * go0 * rh, xo1 = (f32x4){bf_lo(wo.z), bf_hi(wo.z), bf_lo(wo.w), bf_hi(wo.w)} * go1 * rh;
                        const f32x4 xp0 = (f32x4){bf_lo(wp.x), bf_hi(wp.x), bf_lo(wp.y), bf_hi(wp.y)} * gp0 * rh, xp1 = (f32x4){bf_lo(wp.z), bf_hi(wp.z), bf_lo(wp.w), bf_hi(wp.w)} * gp1 * rh;
                        f32x4 o0, o1;
                        if (fq < 2) { o0 = xo0 * c0 - xp0 * s0; o1 = xo1 * c1 - xp1 * s1; } else { o0 = xo0 * c0 + xp0 * s0; o1 = xo1 * c1 + xp1 * s1; }
                        v4u w; w.x = cvt_pk_bf16(o0[0], o0[1]); w.y = cvt_pk_bf16(o0[2], o0[3]); w.z = cvt_pk_bf16(o1[0], o1[1]); w.w = cvt_pk_bf16(o1[2], o1[3]);
                        *(GAS v4u*)(KBp + (size_t)row * 768 + head * 96 + 64 + ro) = w;
                        asm volatile("" ::: "memory"); }
            }
        }
    }
};
struct EpiUkvV {
    static constexpr bool PERM = true; static __device__ __forceinline__ bool chained(const Unit&) { return false; }
    gws_t ws;
    __device__ __forceinline__ void stash(const Unit& u, int tid, PG8_LAS unsigned* st) const {
        if (tid < BM) { gcf32 sp = (gcf32)(ws + WS_SSLAT) + (size_t)(u.pm * BM + tid) * 24;
            const f32x4 a = *(const GAS f32x4*)(sp + 12), b = *(const GAS f32x4*)(sp + 16);
            st[tid] = __float_as_uint(1.0f / sqrtf((((a[0] + a[1]) + (a[2] + a[3])) + ((b[0] + b[1]) + (b[2] + b[3]))) * (1.f / KVRANK) + EPS)); }
    }
    __device__ __forceinline__ void operator()(Acc& acc, const Unit& u, int wr, int wc, const PG8_LAS unsigned* st) const {
        const int ln_ = fresh_lane(), fr = ln_ & 15, fq = ln_ >> 4;
        const int r0 = wr * 64 + fr;
        gbf Vp = (gbf)(ws + WS_KVR); const int col0 = u.pn * BM + wc * 32 + 8 * fq;
#pragma unroll
        for (int ai = 0; ai < 2; ++ai)
#pragma unroll
            for (int m = 0; m < 4; ++m) { const int r = r0 + ai * HALF + m * 16; const float rc = __uint_as_float(st[r]);
                gbf rowp = Vp + (size_t)(u.pm * BM + r) * 512 + col0;
#pragma unroll
                for (int bj = 0; bj < 2; ++bj) { const f32x4 v0 = acc[ai][bj][m][0] * rc, v1 = acc[ai][bj][m][1] * rc;
                    v4u w; w.x = cvt_pk_bf16(v0[0], v0[1]); w.y = cvt_pk_bf16(v0[2], v0[3]); w.z = cvt_pk_bf16(v1[0], v1[1]); w.w = cvt_pk_bf16(v1[2], v1[3]);
                    *(GAS v4u*)(rowp + bj * HALF) = w; } }
    }
};
struct EpiPlain {
    static constexpr bool PERM = true; static __device__ __forceinline__ bool chained(const Unit&) { return false; } __device__ __forceinline__ void stash(const Unit&, int, PG8_LAS unsigned*) const {}
    gbf O; int ldc;
    __device__ __forceinline__ void operator()(Acc& acc, const Unit& u, int wr, int wc, const PG8_LAS unsigned* st) const {
        const int ln_ = fresh_lane(), fr = ln_ & 15, fq = ln_ >> 4;
        const int row0 = u.pm * BM + wr * 64 + fr, col0 = u.pn * BM + wc * 32 + 8 * fq;
#pragma unroll
        for (int ai = 0; ai < 2; ++ai)
#pragma unroll
            for (int m = 0; m < 4; ++m) { gbf rowp = O + (size_t)(row0 + ai * HALF + m * 16) * ldc + col0;
#pragma unroll
                for (int bj = 0; bj < 2; ++bj) { const f32x4 v0 = acc[ai][bj][m][0], v1 = acc[ai][bj][m][1];
                    v4u w; w.x = cvt_pk_bf16(v0[0], v0[1]); w.y = cvt_pk_bf16(v0[2], v0[3]); w.z = cvt_pk_bf16(v1[0], v1[1]); w.w = cvt_pk_bf16(v1[2], v1[3]);
                    *(GAS v4u*)(rowp + bj * HALF) = w; } }
    }
};
struct EpiBranch {
    static constexpr bool PERM = true; static __device__ __forceinline__ bool chained(const Unit& u) { return u.e == 0; } __device__ __forceinline__ void stash(const Unit&, int, PG8_LAS unsigned*) const {}
    gbf O; const GAS unsigned char* G;
    static __device__ __forceinline__ float dq(unsigned w, int k) { return ((float)((w >> (8 * k)) & 255u) + 0.5f) * (1.f / 256.f); }
    __device__ __forceinline__ void operator()(Acc& acc, const Unit& u, int wr, int wc, const PG8_LAS unsigned* st) const {
        const int ln_ = fresh_lane(), fr = ln_ & 15, fq = ln_ >> 4;
        const int row0 = u.pm * BM + wr * 64 + fr, col0 = u.pn * BM + wc * 32 + 8 * fq, gcol = u.pn * BM + wc * 64 + fq * 16;
#pragma unroll
        for (int ai = 0; ai < 2; ++ai) { v4u gbv[4], gav[4];
#pragma unroll
            for (int m = 0; m < 4; ++m) { const size_t r = (size_t)(row0 + ai * HALF + m * 16);
                gbv[m] = *(const GAS v4u*)(G + r * 2048 + 1024 + gcol);
                if (u.e == 0) gav[m] = *(const GAS v4u*)(G + r * 2048 + gcol); }
#pragma unroll
            for (int m = 0; m < 4; ++m) { const size_t r = (size_t)(row0 + ai * HALF + m * 16);
#pragma unroll
                for (int bj = 0; bj < 2; ++bj) { f32x4& v0 = acc[ai][bj][m][0]; f32x4& v1 = acc[ai][bj][m][1];
                    const unsigned b0 = gbv[m][2 * bj], b1 = gbv[m][2 * bj + 1];
                    const float sb[8] = { dq(b0, 0), dq(b0, 1), dq(b0, 2), dq(b0, 3), dq(b1, 0), dq(b1, 1), dq(b1, 2), dq(b1, 3) };
                    if (u.e == 0) {
                        const unsigned a0 = gav[m][2 * bj], a1 = gav[m][2 * bj + 1];
                        const float sa[8] = { dq(a0, 0), dq(a0, 1), dq(a0, 2), dq(a0, 3), dq(a1, 0), dq(a1, 1), dq(a1, 2), dq(a1, 3) };
#pragma unroll
                        for (int q = 0; q < 4; ++q) { v0[q] *= sa[q] * __builtin_amdgcn_rcpf(sb[q]); v1[q] *= sa[4 + q] * __builtin_amdgcn_rcpf(sb[4 + q]); }
                    } else {
                        v4u w; w.x = cvt_pk_bf16(v0[0] * sb[0], v0[1] * sb[1]); w.y = cvt_pk_bf16(v0[2] * sb[2], v0[3] * sb[3]); w.z = cvt_pk_bf16(v1[0] * sb[4], v1[1] * sb[5]); w.w = cvt_pk_bf16(v1[2] * sb[6], v1[3] * sb[7]);
                        *(GAS v4u*)(O + r * D + col0 + bj * HALF) = w; } } } }
    }
};
template <bool F32IN> struct EpiResidB {
    static constexpr bool PERM = true; static __device__ __forceinline__ bool chained(const Unit&) { return false; } __device__ __forceinline__ void stash(const Unit&, int, PG8_LAS unsigned*) const {}
    const GAS void* base; gbf out;
    __device__ __forceinline__ void operator()(Acc& acc, const Unit& u, int wr, int wc, const PG8_LAS unsigned* st) const {
        const int ln_ = fresh_lane(), fr = ln_ & 15, fq = ln_ >> 4;
        const int row0 = u.pm * BM + wr * 64 + fr, col0 = u.pn * BM + wc * 32 + 8 * fq;
#pragma unroll
        for (int ai = 0; ai < 2; ++ai)
#pragma unroll
            for (int mp = 0; mp < 2; ++mp) { f32x4 b[2][2][2];
#pragma unroll
                for (int mm = 0; mm < 2; ++mm) { const size_t off = (size_t)(row0 + ai * HALF + (2 * mp + mm) * 16) * D + col0;
#pragma unroll
                    for (int bj = 0; bj < 2; ++bj) {
                        if (F32IN) { b[mm][bj][0] = *(const GAS f32x4*)((gcf32)base + off + bj * HALF); b[mm][bj][1] = *(const GAS f32x4*)((gcf32)base + off + bj * HALF + 4); }
                        else { const v4u w = *(const GAS v4u*)((gcbf)base + off + bj * HALF);
                            b[mm][bj][0] = (f32x4){bf_lo(w.x), bf_hi(w.x), bf_lo(w.y), bf_hi(w.y)}; b[mm][bj][1] = (f32x4){bf_lo(w.z), bf_hi(w.z), bf_lo(w.w), bf_hi(w.w)}; } } }
#pragma unroll
                for (int mm = 0; mm < 2; ++mm) { const size_t off = (size_t)(row0 + ai * HALF + (2 * mp + mm) * 16) * D + col0;
#pragma unroll
                    for (int bj = 0; bj < 2; ++bj) { const f32x4 v0 = b[mm][bj][0] + acc[ai][bj][2 * mp + mm][0], v1 = b[mm][bj][1] + acc[ai][bj][2 * mp + mm][1];
                        v4u w; w.x = cvt_pk_bf16(v0[0], v0[1]); w.y = cvt_pk_bf16(v0[2], v0[3]); w.z = cvt_pk_bf16(v1[0], v1[1]); w.w = cvt_pk_bf16(v1[2], v1[3]);
                        *(GAS v4u*)(out + off + bj * HALF) = w; } } }
    }
};
struct EpiSwiGLU {
    static constexpr bool PERM = true; static __device__ __forceinline__ bool chained(const Unit&) { return false; } __device__ __forceinline__ void stash(const Unit&, int, PG8_LAS unsigned*) const {}
    gbf O;
    __device__ __forceinline__ void operator()(Acc& acc, const Unit& u, int wr, int wc, const PG8_LAS unsigned* st) const {
        const int ln_ = fresh_lane(), fr = ln_ & 15, fq = ln_ >> 4;
        const int row0 = u.pm * BM + wr * 64 + fr, col0 = u.pn * 128 + wc * 32 + 8 * fq;
#pragma unroll
        for (int ai = 0; ai < 2; ++ai)
#pragma unroll
            for (int m = 0; m < 4; ++m) { gbf rowp = O + (size_t)(row0 + ai * HALF + m * 16) * DFF + col0; float o[8];
#pragma unroll
                for (int n = 0; n < 2; ++n) { const f32x4 g = acc[ai][0][m][n], up = acc[ai][1][m][n];
#pragma unroll
                    for (int e = 0; e < 4; ++e) o[4 * n + e] = g[e] * fast_sigmoid(g[e]) * up[e]; }
                v4u w; w.x = cvt_pk_bf16(o[0], o[1]); w.y = cvt_pk_bf16(o[2], o[3]); w.z = cvt_pk_bf16(o[4], o[5]); w.w = cvt_pk_bf16(o[6], o[7]);
                *(GAS v4u*)rowp = w; }
    }
};
struct EpiMoeDown {
    static constexpr bool PERM = true; static __device__ __forceinline__ bool chained(const Unit&) { return false; }
    gbf Y; const volatile PG8_LAS int* tab; const GAS int* list; gcf32 tokp; gbf KP; GAS int* tslot;
    __device__ __forceinline__ void stash(const Unit& u, int tid, PG8_LAS unsigned* st) const {
        if (tid < BM) { const int pos = (u.pm - tab[u.e]) * BM + tid; unsigned dst = 0xffffffffu; float p = 0.f;
            if (pos < tab[16 + u.e]) { const int ent = list[u.e * 32768 + pos]; dst = (unsigned)((ent & 1) * M + (ent >> 1)); p = tokp[ent]; }
            st[2 * tid] = dst; st[2 * tid + 1] = __float_as_uint(p); }
    }
    __device__ __forceinline__ void operator()(Acc& acc, const Unit& u, int wr, int wc, const PG8_LAS unsigned* st) const {
        const int ln_ = fresh_lane(), fr = ln_ & 15, fq = ln_ >> 4;
        const int col0 = u.pn * BM + wc * 32 + 8 * fq;
        const int r0 = wr * 64 + fr;
        if (u.part >= 0) {
            gbf slab = KP + (size_t)u.part * (BM * BM) + wc * 32 + 8 * fq;
#pragma unroll
            for (int ai = 0; ai < 2; ++ai)
#pragma unroll
                for (int m = 0; m < 4; ++m) { const int r = r0 + ai * HALF + m * 16; const unsigned dst = st[2 * r]; const float p = __uint_as_float(st[2 * r + 1]);
                    if (dst != 0xffffffffu) {
#pragma unroll
                        for (int bj = 0; bj < 2; ++bj) { const f32x4 v0 = acc[ai][bj][m][0] * p, v1 = acc[ai][bj][m][1] * p;
                            v4u w; w.x = cvt_pk_bf16(v0[0], v0[1]); w.y = cvt_pk_bf16(v0[2], v0[3]); w.z = cvt_pk_bf16(v1[0], v1[1]); w.w = cvt_pk_bf16(v1[2], v1[3]);
                            *(GAS v4u*)(slab + (size_t)r * BM + bj * HALF) = w; }
                        if (u.part % KPARTS == 0 && wc == 0 && fq == 0) tslot[(size_t)dst * 4 + u.pn] = (u.part << 8) | r; } }
            return;
        }
#pragma unroll
        for (int ai = 0; ai < 2; ++ai)
#pragma unroll
            for (int m = 0; m < 4; ++m) { const int r = r0 + ai * HALF + m * 16; const unsigned dst = st[2 * r]; const float p = __uint_as_float(st[2 * r + 1]);
                if (dst != 0xffffffffu) {
                    gbf rowp = Y + (size_t)dst * D + col0;
#pragma unroll
                    for (int bj = 0; bj < 2; ++bj) { const f32x4 v0 = acc[ai][bj][m][0] * p, v1 = acc[ai][bj][m][1] * p;
                        v4u w; w.x = cvt_pk_bf16(v0[0], v0[1]); w.y = cvt_pk_bf16(v0[2], v0[3]); w.z = cvt_pk_bf16(v1[0], v1[1]); w.w = cvt_pk_bf16(v1[2], v1[3]);
                        *(GAS v4u*)(rowp + bj * HALF) = w; } } }
    }
};
}

namespace att {
typedef LAS const char* lds_cptr;
__device__ __forceinline__ int crow(int r, int hi) { return (r & 3) + 8 * (r >> 2) + 4 * hi; }
__device__ __forceinline__ void glds16(const GAS void* gsrc, unsigned lds_dst) { unsigned keep;
    asm volatile("s_mov_b32 %0, m0\n\ts_mov_b32 m0, %2\n\ts_nop 0\n\tglobal_load_lds_dwordx4 %1, off\n\ts_mov_b32 m0, %0" : "=&s"(keep) : "v"(gsrc), "s"(lds_dst) : "memory"); }
#define ATT_WAIT_BAR() asm volatile("s_waitcnt vmcnt(0) lgkmcnt(0)\n\ts_barrier" ::: "memory")
__device__ __forceinline__ float swap_half(float v, int hi) { auto rr = __builtin_amdgcn_permlane32_swap(__float_as_uint(v), __float_as_uint(v), false, false); return __uint_as_float(hi ? rr[0] : rr[1]); }

typedef short v4i16_t __attribute__((ext_vector_type(4)));
__device__ __forceinline__ s16x4 vtr(lds_cptr p) { return __builtin_bit_cast(s16x4, __builtin_amdgcn_ds_read_tr16_b64_v4i16((LAS v4i16_t*)p)); }
__device__ __forceinline__ void pv(f32x16* o, int vb, bf16x8 pa0, bf16x8 pa1, bf16x8 pa2, bf16x8 pa3) {
#pragma unroll
    for (int d0 = 0; d0 < 2; ++d0) { s16x4 lo[4], hi[4];
#pragma unroll
        for (int ks = 0; ks < 4; ++ks) {
            asm volatile("ds_read_b64_tr_b16 %0,%1 offset:%c2" : "=&v"(lo[ks]) : "v"(vb), "i"(d0 * 4096 + ks * 1024) : "memory");
            asm volatile("ds_read_b64_tr_b16 %0,%1 offset:%c2" : "=&v"(hi[ks]) : "v"(vb), "i"(d0 * 4096 + ks * 1024 + 512) : "memory"); }
        asm volatile("s_waitcnt lgkmcnt(0)" ::: "memory"); __builtin_amdgcn_sched_barrier(0);
#define ATT_PK(k) (bf16x8){lo[k][0], lo[k][1], lo[k][2], lo[k][3], hi[k][0], hi[k][1], hi[k][2], hi[k][3]}
        o[d0] = __builtin_amdgcn_mfma_f32_32x32x16_bf16(pa0, ATT_PK(0), o[d0], 0, 0, 0);
        o[d0] = __builtin_amdgcn_mfma_f32_32x32x16_bf16(pa1, ATT_PK(1), o[d0], 0, 0, 0);
        o[d0] = __builtin_amdgcn_mfma_f32_32x32x16_bf16(pa2, ATT_PK(2), o[d0], 0, 0, 0);
        o[d0] = __builtin_amdgcn_mfma_f32_32x32x16_bf16(pa3, ATT_PK(3), o[d0], 0, 0, 0);
#undef ATT_PK
    }
}

template <int DQK, bool MOBA>
__device__ __forceinline__ void attn_unit(int wave0, int b, int h, int qb, gcbf Q, int ldq, gcbf K, int ldk, gcbf V, int ldv, gbf O, int ldo,
                                          LAS unsigned char* shm, gcf32 kmean_bh, gcf32 qgain, gcf32 ropeB) {
    constexpr int ND0 = DQK / 16, NCH = DQK / 8, KSLOT = NCH * 1024, NSL = 4;
    constexpr int LDS_K = 0, LDS_V = NSL * KSLOT, LDS_WS = LDS_V + NSL * 8192, LDS_OST = LDS_WS + 2048, LDS_KM = LDS_OST + 32768;
    static_assert(LDS_KM + 4096 <= RING_BYTES, "attention LDS");
    const int tid = phase_tid(wave0);
    const int lane = tid & 63, r32 = lane & 31, hi = lane >> 5; const int wid = __builtin_amdgcn_readfirstlane(tid >> 6);
    const long rowbase = (long)b * SEQ; const int q0 = qb * 256;
    gcbf Qw = Q + (rowbase + q0 + wid * 32) * ldq + h * DQK;
    gcbf Kh = K + rowbase * ldk + h * DQK; gcbf Vh = V + rowbase * ldv + h * 64;
    const unsigned lds0 = (unsigned)(uintptr_t)shm;
    LAS float* wsf = (LAS float*)(shm + LDS_WS) + wid * 64;
    LAS float* kml = (LAS float*)(shm + LDS_KM);
    const int NT = 4 * (qb + 1);
#define ATT_DMA(t, s) do { \
        for (int c_ = wid; c_ < NCH; c_ += 8) glds16(Kh + (long)((t) * 64 + lane) * ldk + c_ * 8, (unsigned)__builtin_amdgcn_readfirstlane(lds0 + LDS_K + (s) * KSLOT + c_ * 1024)); \
        glds16(Vh + (long)((t) * 64 + 16 * (wid & 3) + (lane >> 2)) * ldv + (wid >> 2) * 32 + (lane & 3) * 8, (unsigned)__builtin_amdgcn_readfirstlane(lds0 + LDS_V + (s) * 8192 + wid * 1024)); } while (0)
    if (MOBA) { for (int i = tid; i < qb * 64; i += 512) { const int n = i >> 6, d = i & 63; kml[i] = (kmean_bh[(size_t)n * 1024 + d] + kmean_bh[(size_t)n * 1024 + 512 + d]) * (1.f / 256.f); } }
    bf16x8 qr[ND0];
#pragma unroll
    for (int d0 = 0; d0 < ND0; ++d0) qr[d0] = *(const GAS bf16x8*)(Qw + (long)r32 * ldq + d0 * 16 + hi * 8);
    if constexpr (!MOBA) {
        float qf[ND0][8]; float ss = 0.f;
#pragma unroll
        for (int d0 = 0; d0 < ND0; ++d0)
#pragma unroll
            for (int j = 0; j < 8; ++j) { qf[d0][j] = __uint_as_float(((unsigned)(unsigned short)qr[d0][j]) << 16); ss += qf[d0][j] * qf[d0][j]; }
        ss += swap_half(ss, hi);
        const float rstd = 1.0f / sqrtf(ss * (1.f / 96.f) + EPS) * C2B;
#pragma unroll
        for (int d0 = 0; d0 < ND0; ++d0)
#pragma unroll
            for (int j = 0; j < 8; ++j) qf[d0][j] *= rstd * qgain[d0 * 16 + hi * 8 + j];
        const int pos = q0 + wid * 32 + r32;
#pragma unroll
        for (int j = 0; j < 8; ++j) { const float c = ropeB[pos * 16 + 8 * hi + j], s = ropeB[4096 * 16 + pos * 16 + 8 * hi + j]; const float x1 = qf[4][j], x2 = qf[5][j]; qf[4][j] = x1 * c - x2 * s; qf[5][j] = x2 * c + x1 * s; }
#pragma unroll
        for (int d0 = 0; d0 < ND0; ++d0) { v4u w; w.x = cvt_pk_bf16(qf[d0][0], qf[d0][1]); w.y = cvt_pk_bf16(qf[d0][2], qf[d0][3]); w.z = cvt_pk_bf16(qf[d0][4], qf[d0][5]); w.w = cvt_pk_bf16(qf[d0][6], qf[d0][7]); qr[d0] = __builtin_bit_cast(bf16x8, w); }
    }
    ATT_DMA(0, 0); ATT_DMA(1, 1); ATT_DMA(2, 2);
    unsigned selmask = 0xffffffffu;
    if (MOBA) {
        __syncthreads();
        if (qb <= 3) selmask = (1u << qb) - 1u;
        else {
            float b1 = -INFINITY, b2 = -INFINITY, b3 = -INFINITY; int i1 = 0, i2 = 0, i3 = 0;
            for (int n = 0; n < qb; ++n) {
                float g = 0.f;
#pragma unroll
                for (int d0 = 0; d0 < ND0; ++d0)
#pragma unroll
                    for (int j = 0; j < 8; ++j) g += __uint_as_float(((unsigned)(unsigned short)qr[d0][j]) << 16) * kml[n * 64 + d0 * 16 + hi * 8 + j];
                g += swap_half(g, hi);
                if (g > b1) { b3 = b2; i3 = i2; b2 = b1; i2 = i1; b1 = g; i1 = n; }
                else if (g > b2) { b3 = b2; i3 = i2; b2 = g; i2 = n; }
                else if (g > b3) { b3 = g; i3 = n; }
            }
            selmask = (1u << i1) | (1u << i2) | (1u << i3);
        }
    }
    float m_ref = 0.f, l_reg = 0.f; f32x16 o[2]; o[0] = f32x16{}; o[1] = f32x16{};
    f32x16 negm = f32x16{};
    const int qrel = wid * 32 + r32;
    const lds_cptr vp0 = (lds_cptr)shm + LDS_V + ((lane >> 4) & 1) * 32 + (lane & 3) * 8 + (4 * hi + ((lane & 15) >> 2)) * 64;
#define ATT_TILE(t, FIRST, DIAG) do { \
        if (wid < NCH - 8) asm volatile("s_waitcnt vmcnt(6) lgkmcnt(0)\n\ts_barrier" ::: "memory"); \
        else asm volatile("s_waitcnt vmcnt(4) lgkmcnt(0)\n\ts_barrier" ::: "memory"); \
        { const int tn = ((t) + 3 < NT) ? (t) + 3 : NT - 1; ATT_DMA(tn, ((t) + 3) & 3); } \
        const int slot = (t) & 3; \
        f32x16 p0, p1; \
          \
        bf16x8 kf[2 * ND0]; s16x4 vlo[8], vhi[8]; \
        { lds_cptr kb = (lds_cptr)shm + LDS_K + slot * KSLOT + hi * 1024 + r32 * 16; \
          _Pragma("unroll") for (int d0 = 0; d0 < ND0; ++d0) { kf[2 * d0] = *(const LAS bf16x8*)(kb + d0 * 2048); kf[2 * d0 + 1] = *(const LAS bf16x8*)(kb + d0 * 2048 + 512); } \
          lds_cptr vp_ = vp0 + slot * 8192; \
          _Pragma("unroll") for (int i = 0; i < 8; ++i) { vlo[i] = vtr(vp_ + ((i >> 2) * 4096 + (i & 3) * 1024)); vhi[i] = vtr(vp_ + ((i >> 2) * 4096 + (i & 3) * 1024 + 512)); } \
          __builtin_amdgcn_sched_barrier(0); \
          _Pragma("unroll") for (int d0 = 0; d0 < ND0; ++d0) { \
              if (d0 == 0) { p0 = __builtin_amdgcn_mfma_f32_32x32x16_bf16(kf[0], qr[0], negm, 0, 0, 0); p1 = __builtin_amdgcn_mfma_f32_32x32x16_bf16(kf[1], qr[0], negm, 0, 0, 0); } \
              else { p0 = __builtin_amdgcn_mfma_f32_32x32x16_bf16(kf[2 * d0], qr[d0], p0, 0, 0, 0); p1 = __builtin_amdgcn_mfma_f32_32x32x16_bf16(kf[2 * d0 + 1], qr[d0], p1, 0, 0, 0); } } } \
        if (DIAG) { const int kb_ = 64 * ((t) & 3) + 4 * hi; \
            _Pragma("unroll") for (int r = 0; r < 16; ++r) { const int kv = kb_ + (r & 3) + 8 * (r >> 2); if (kv > qrel) p0[r] = -INFINITY; if (kv + 32 > qrel) p1[r] = -INFINITY; } } \
        float ra = fmaxf(fmaxf(p0[0], p0[1]), p1[0]), rb = fmaxf(fmaxf(p0[2], p0[3]), p1[1]); ra = fmaxf(fmaxf(ra, p1[2]), p1[3]); \
        _Pragma("unroll") for (int r = 4; r < 16; r += 4) { ra = fmaxf(fmaxf(ra, p0[r]), p0[r + 1]); rb = fmaxf(fmaxf(rb, p0[r + 2]), p0[r + 3]); ra = fmaxf(fmaxf(ra, p1[r]), p1[r + 1]); rb = fmaxf(fmaxf(rb, p1[r + 2]), p1[r + 3]); } \
        float rm = fmaxf(ra, rb); rm = fmaxf(rm, swap_half(rm, hi)); \
        if (FIRST) { m_ref = fmaxf(rm, -1e30f); \
            _Pragma("unroll") for (int r = 0; r < 16; ++r) { p0[r] -= m_ref; p1[r] -= m_ref; negm[r] = -m_ref; } \
        } else if (__any(rm > 8.0f)) {                         \
            const float dl = fmaxf(rm, 0.f), alpha = __builtin_amdgcn_exp2f(-dl); \
            m_ref += dl; l_reg *= alpha; \
            _Pragma("unroll") for (int r = 0; r < 16; ++r) { p0[r] -= dl; p1[r] -= dl; negm[r] = -m_ref; } \
            if (hi == 0) wsf[r32] = alpha; \
            LDS_WAIT(); \
            _Pragma("unroll") for (int r = 0; r < 16; ++r) { const float a = wsf[crow(r, hi)]; o[0][r] *= a; o[1][r] *= a; } } \
        float sacc = 0.f; \
        _Pragma("unroll") for (int r = 0; r < 16; ++r) { p0[r] = __builtin_amdgcn_exp2f(p0[r]); p1[r] = __builtin_amdgcn_exp2f(p1[r]); sacc += p0[r] + p1[r]; } \
        l_reg += sacc; \
        v4u pw0, pw1, pw2, pw3; \
        pw0 = (v4u){cvt_pk_bf16(p0[0], p0[1]), cvt_pk_bf16(p0[2], p0[3]), cvt_pk_bf16(p0[4], p0[5]), cvt_pk_bf16(p0[6], p0[7])}; \
        pw1 = (v4u){cvt_pk_bf16(p0[8], p0[9]), cvt_pk_bf16(p0[10], p0[11]), cvt_pk_bf16(p0[12], p0[13]), cvt_pk_bf16(p0[14], p0[15])}; \
        pw2 = (v4u){cvt_pk_bf16(p1[0], p1[1]), cvt_pk_bf16(p1[2], p1[3]), cvt_pk_bf16(p1[4], p1[5]), cvt_pk_bf16(p1[6], p1[7])}; \
        pw3 = (v4u){cvt_pk_bf16(p1[8], p1[9]), cvt_pk_bf16(p1[10], p1[11]), cvt_pk_bf16(p1[12], p1[13]), cvt_pk_bf16(p1[14], p1[15])}; \
        { const bf16x8 pa[4] = { __builtin_bit_cast(bf16x8, pw0), __builtin_bit_cast(bf16x8, pw1), __builtin_bit_cast(bf16x8, pw2), __builtin_bit_cast(bf16x8, pw3) }; \
          _Pragma("unroll") for (int i = 0; i < 8; ++i) { const bf16x8 vf = (bf16x8){vlo[i][0], vlo[i][1], vlo[i][2], vlo[i][3], vhi[i][0], vhi[i][1], vhi[i][2], vhi[i][3]}; \
              o[i >> 2] = __builtin_amdgcn_mfma_f32_32x32x16_bf16(pa[i & 3], vf, o[i >> 2], 0, 0, 0); } } \
    } while (0)
    static_assert(!MOBA, "this body serves the MLA mixer; MoBA runs att64::attn_unit");
    if (NT == 4) { ATT_TILE(0, true, true); for (int t = 1; t < 4; ++t) ATT_TILE(t, false, true); }
    else { ATT_TILE(0, true, false); for (int t = 1; t < NT - 4; ++t) ATT_TILE(t, false, false); for (int t = NT - 4; t < NT; ++t) ATT_TILE(t, false, true); }
#undef ATT_TILE
    l_reg += swap_half(l_reg, hi);
    if (hi == 0) wsf[32 + r32] = l_reg;
    LDS_WAIT();
    float rli[16];
#pragma unroll
    for (int r = 0; r < 16; ++r) rli[r] = __builtin_amdgcn_rcpf(wsf[32 + crow(r, hi)]);
    gbf Ow = O + (rowbase + q0 + wid * 32) * ldo + h * 64;
    { LAS bf16* stg = (LAS bf16*)(shm + LDS_OST) + wid * 2048;
#pragma unroll
      for (int r = 0; r < 16; ++r) { const int orow = crow(r, hi);
#pragma unroll
          for (int d0 = 0; d0 < 2; ++d0) stg[orow * 64 + d0 * 32 + r32] = (bf16)(cvt_pk_bf16(o[d0][r] * rli[r], 0.f) & 0xffffu); }
      LDS_WAIT();
#pragma unroll
      for (int i = 0; i < 4; ++i) { const int row = i * 8 + (lane >> 3), ch = lane & 7; const v4u v = *(const LAS v4u*)(stg + row * 64 + ch * 8); *(GAS v4u*)(Ow + (long)row * ldo + ch * 8) = v; } }
    asm volatile("s_waitcnt vmcnt(0) lgkmcnt(0)\n\ts_barrier" ::: "memory");
#undef ATT_DMA
}
}

namespace att64 {
using bf16x8=__attribute__((ext_vector_type(8)))short;
using s16x4=__attribute__((ext_vector_type(4)))short;
using f32x16=__attribute__((ext_vector_type(16)))float;
using u32x4=__attribute__((ext_vector_type(4)))unsigned;
constexpr int SEQ=4096,D=64,DM=512;
constexpr int NW=8,QBLK=32,QB=QBLK*NW,KVBLK=64;
typedef LAS const char* lds_cptr;
typedef short v4i16_t __attribute__((ext_vector_type(4)));
__device__ __forceinline__ int crow(int r,int hi){return (r&3)+8*(r>>2)+4*hi;}
#define SBAR() __builtin_amdgcn_sched_barrier(0)
__device__ __forceinline__ void cmask(f32x16&p0,f32x16&p1,int jb,int qrel,int hi){
  const float NEG=-INFINITY; int kb=64*jb+4*hi;
  #pragma unroll
  for(int r=0;r<16;++r){int kv=kb+(r&3)+8*(r>>2); if(kv>qrel)p0[r]=NEG; if(kv+32>qrel)p1[r]=NEG;}
}

constexpr int NSLOT=3;
constexpr float NEGB=-30000.f;
__device__ __forceinline__ void glds16(const GAS void*gsrc,unsigned lds_dst){unsigned keep;
  asm volatile("s_mov_b32 %0, m0\n\ts_mov_b32 m0, %2\n\ts_nop 0\n\tglobal_load_lds_dwordx4 %1, off\n\ts_mov_b32 m0, %0":"=&s"(keep):"v"(gsrc),"s"(lds_dst):"memory");}
__device__ __forceinline__ float max3f(float a,float b,float c){float r;asm("v_max3_f32 %0, %1, %2, %3":"=v"(r):"v"(a),"v"(b),"v"(c));return r;}
__device__ __forceinline__ float max2f(float a,float b){float r;asm("v_max_f32_e32 %0, %1, %2":"=v"(r):"v"(a),"v"(b));return r;}
__device__ __forceinline__ float fadd_s(float a,float b){float r;asm("v_add_f32_e32 %0, %1, %2":"=v"(r):"v"(a),"v"(b));return r;}
__device__ __forceinline__ float fsub_s(float a,float b){float r;asm("v_sub_f32_e32 %0, %1, %2":"=v"(r):"v"(a),"v"(b));return r;}
typedef float f32x2_t __attribute__((ext_vector_type(2))); typedef __bf16 bf16x2_t __attribute__((ext_vector_type(2)));
__device__ __forceinline__ unsigned cvtpk_s(float lo,float hi){f32x2_t v={lo,hi};bf16x2_t b=__builtin_convertvector(v,bf16x2_t);return __builtin_bit_cast(unsigned,b);}
#define WAIT_BAR(N) asm volatile("s_waitcnt vmcnt(" #N ") lgkmcnt(0)\n\ts_barrier":::"memory")

template<int ND0> __device__ __forceinline__ void qkt(f32x16&p0,f32x16&p1,lds_cptr Kslot,const bf16x8*qr,const f32x16&negm,int r32,int hi){
  lds_cptr kb=Kslot+hi*1024+r32*16;
  #pragma unroll
  for(int d0=0;d0<ND0;++d0){
    const bf16x8 b0=*(const LAS bf16x8*)(kb+d0*2048);
    const bf16x8 b1=*(const LAS bf16x8*)(kb+d0*2048+512);
    if(d0==0){p0=__builtin_amdgcn_mfma_f32_32x32x16_bf16(b0,qr[0],negm,0,0,0);p1=__builtin_amdgcn_mfma_f32_32x32x16_bf16(b1,qr[0],negm,0,0,0);}
    else{p0=__builtin_amdgcn_mfma_f32_32x32x16_bf16(b0,qr[d0],p0,0,0,0);p1=__builtin_amdgcn_mfma_f32_32x32x16_bf16(b1,qr[d0],p1,0,0,0);}}
}
template<int ND0> __device__ __forceinline__ void kloadN(bf16x8*kf,lds_cptr kp){
  #pragma unroll
  for(int j=0;j<ND0;++j){ kf[2*j]=*(const __attribute__((address_space(3))) bf16x8*)(kp+j*2048); kf[2*j+1]=*(const __attribute__((address_space(3))) bf16x8*)(kp+j*2048+512); }
}
__device__ __forceinline__ void kload2(bf16x8*kf,lds_cptr kp,int j){ kf[2*j]=*(const __attribute__((address_space(3))) bf16x8*)(kp+j*2048); kf[2*j+1]=*(const __attribute__((address_space(3))) bf16x8*)(kp+j*2048+512); }
__device__ __forceinline__ s16x4 vtr(lds_cptr p){ return __builtin_bit_cast(s16x4,__builtin_amdgcn_ds_read_tr16_b64_v4i16((__attribute__((address_space(3))) v4i16_t*)p)); }
__device__ __forceinline__ float rowmax(const f32x16&p0,const f32x16&p1){
  float a=max3f(p0[0],p0[1],p1[0]),b=max3f(p0[2],p0[3],p1[1]);a=max3f(a,p1[2],p1[3]);
  #pragma unroll
  for(int r=4;r<16;r+=4){a=max3f(a,p0[r],p0[r+1]);b=max3f(b,p0[r+2],p0[r+3]);a=max3f(a,p1[r],p1[r+1]);b=max3f(b,p1[r+2],p1[r+3]);}
  const float m=max2f(a,b);
  auto rr=__builtin_amdgcn_permlane32_swap(__float_as_uint(m),__float_as_uint(m),false,false);
  return max2f(__uint_as_float(rr[0]),__uint_as_float(rr[1]));
}
__device__ __forceinline__ void pv(f32x16*o,int vb,bf16x8 pa0,bf16x8 pa1,bf16x8 pa2,bf16x8 pa3){
  #pragma unroll
  for(int d0=0;d0<2;++d0){s16x4 lo[4],hi[4];
    #pragma unroll
    for(int ks=0;ks<4;++ks){
      asm volatile("ds_read_b64_tr_b16 %0,%1 offset:%c2":"=&v"(lo[ks]):"v"(vb),"i"(d0*4096+ks*1024):"memory");
      asm volatile("ds_read_b64_tr_b16 %0,%1 offset:%c2":"=&v"(hi[ks]):"v"(vb),"i"(d0*4096+ks*1024+512):"memory");}
    asm volatile("s_waitcnt lgkmcnt(0)":::"memory");SBAR();
    #define PK(k) (bf16x8){lo[k][0],lo[k][1],lo[k][2],lo[k][3],hi[k][0],hi[k][1],hi[k][2],hi[k][3]}
    o[d0]=__builtin_amdgcn_mfma_f32_32x32x16_bf16(pa0,PK(0),o[d0],0,0,0);
    o[d0]=__builtin_amdgcn_mfma_f32_32x32x16_bf16(pa1,PK(1),o[d0],0,0,0);
    o[d0]=__builtin_amdgcn_mfma_f32_32x32x16_bf16(pa2,PK(2),o[d0],0,0,0);
    o[d0]=__builtin_amdgcn_mfma_f32_32x32x16_bf16(pa3,PK(3),o[d0],0,0,0);
    #undef PK
  }
}

template<int THRL,int DQ,bool MOBA> __device__ __forceinline__ void attn_unit(int wave0,int b,int h,int qb,gcbf Q,gcbf K,gcbf V,gbf O,LAS unsigned char*shm,gcf32 kmp,gcf32 ropeB){
  constexpr int ND0=DQ/16, NCH=DQ/8, SLOTB=NCH*1024, LDQ=MOBA?512:768, LDK=LDQ;
  constexpr int LDS_K=0, LDS_V=NSLOT*SLOTB, LDS_WS=2*NSLOT*SLOTB, LDS_OST=LDS_WS+NW*64*4, LDS_END=LDS_OST+NW*4096;
  static_assert(LDS_END+4096<=131072,"attention LDS");
  const int tid=phase_tid(wave0),lane=tid&63,r32=lane&31,hi=lane>>5; const int wid=__builtin_amdgcn_readfirstlane(tid>>6);
  const bool kp2=(DQ>64)&&(wid<NCH-8);
  const long rowbase=(long)b*SEQ; const int q0=qb*QB;
  gcbf Qw=Q+(rowbase+q0+wid*QBLK)*LDQ+h*DQ;
  gcbf Kh=K+rowbase*LDK+h*DQ; gcbf Vh=V+rowbase*DM+h*D;
  const unsigned lds0=(unsigned)(uintptr_t)shm;
  LAS float*wsf=(LAS float*)(shm+LDS_WS)+wid*64; LAS float*kml=(LAS float*)(shm+LDS_END);
  gcbf ksrc=Kh+(long)lane*LDK+wid*8;
  gcbf vsrc=Vh+(long)(16*(wid&3)+(lane>>2))*DM+(wid>>2)*32+(lane&3)*8;
  const unsigned kdst=lds0+LDS_K+wid*1024, vdst=lds0+LDS_V+wid*1024;
  #define DMA_K(t,slot) do{ glds16(ksrc+(long)(t)*KVBLK*LDK,(unsigned)__builtin_amdgcn_readfirstlane(kdst+(slot))); \
      if(kp2) glds16(ksrc+(long)(t)*KVBLK*LDK+64,(unsigned)__builtin_amdgcn_readfirstlane(kdst+8192+(slot))); }while(0)
  #define DMA_V(t,slot) glds16(vsrc+(long)(t)*KVBLK*DM,(unsigned)__builtin_amdgcn_readfirstlane(vdst+(slot)))
  #define WB3() do{ if(kp2){WAIT_BAR(5);} else {WAIT_BAR(3);} }while(0)
  #define WB2() do{ if(kp2){WAIT_BAR(3);} else {WAIT_BAR(2);} }while(0)
  const int vb0=(int)(lds0+LDS_V)+((lane>>4)&1)*32+(lane&3)*8+(4*hi+((lane&15)>>2))*64;
  bf16x8 kf[2*ND0];
  const lds_cptr shm3=(lds_cptr)shm; const lds_cptr Kbase=shm3+LDS_K; const lds_cptr kp0=shm3+LDS_K+hi*1024+r32*16; const lds_cptr vp0=shm3+LDS_V+((lane>>4)&1)*32+(lane&3)*8+(4*hi+((lane&15)>>2))*64;
  const int NT=(q0+QB)/KVBLK;
  if constexpr(MOBA){ for(int i=tid;i<qb*64;i+=512){const int n=i>>6,d=i&63; kml[i]=(kmp[(size_t)n*1024+d]+kmp[(size_t)n*1024+512+d])*(1.f/256.f);} }
  DMA_K(0,0);DMA_V(0,0);DMA_K(1,SLOTB);
  bf16x8 qr[ND0];
  #pragma unroll
  for(int d0=0;d0<ND0;++d0)qr[d0]=*(const GAS bf16x8*)(Qw+(long)r32*LDQ+d0*16+hi*8);
  if constexpr(!MOBA){
    float qf[ND0][8]; float ss=0.f;
    #pragma unroll
    for(int d0=0;d0<ND0;++d0)
      #pragma unroll
      for(int j=0;j<8;++j){ qf[d0][j]=__uint_as_float(((unsigned)(unsigned short)qr[d0][j])<<16); ss+=qf[d0][j]*qf[d0][j]; }
    { auto rr=__builtin_amdgcn_permlane32_swap(__float_as_uint(ss),__float_as_uint(ss),false,false); ss=__uint_as_float(rr[0])+__uint_as_float(rr[1]); }
    const float rstd=1.0f/sqrtf(ss*(1.f/96.f)+EPS)*C2B;
    #pragma unroll
    for(int d0=0;d0<ND0;++d0)
      #pragma unroll
      for(int j=0;j<8;++j) qf[d0][j]*=rstd*kmp[d0*16+hi*8+j];
    const int pos=q0+wid*QBLK+r32;
    #pragma unroll
    for(int j=0;j<8;++j){ const float c=ropeB[pos*16+8*hi+j], s=ropeB[4096*16+pos*16+8*hi+j]; const float x1=qf[ND0-2][j], x2=qf[ND0-1][j]; qf[ND0-2][j]=x1*c-x2*s; qf[ND0-1][j]=x2*c+x1*s; }
    #pragma unroll
    for(int d0=0;d0<ND0;++d0){ u32x4 w; w[0]=cvtpk_s(qf[d0][0],qf[d0][1]); w[1]=cvtpk_s(qf[d0][2],qf[d0][3]); w[2]=cvtpk_s(qf[d0][4],qf[d0][5]); w[3]=cvtpk_s(qf[d0][6],qf[d0][7]); qr[d0]=__builtin_bit_cast(bf16x8,w); }
  }
  float mhat=0.f,l_reg=0.f;f32x16 o[2];o[0]=f32x16{};o[1]=f32x16{};f32x16 negm=f32x16{};asm volatile("":"+v"(negm));
  const int qrel=wid*QBLK+r32;
  #define BMASK(P0,P1,t) do{ if constexpr(MOBA){ const bool keep_=(selmask>>((t)>>2))&1u; if(!__all(keep_)){ _Pragma("unroll") for(int r=0;r<16;++r){P0[r]=keep_?P0[r]:NEGB;P1[r]=keep_?P1[r]:NEGB;} } } }while(0)
  #define CMASK(P0,P1,t) do{int jb_=(t)-(NT-4); if(jb_>=0)cmask(P0,P1,jb_,qrel,hi); else BMASK(P0,P1,t);}while(0)
  bool resc=false;
  #define START(P0,P1) do{ const float rm=rowmax(P0,P1); resc=false; \
    { const float dl=max2f(rm,-1000.f); mhat=fadd_s(mhat,dl); \
      _Pragma("unroll") for(int r=0;r<16;++r){P0[r]=fsub_s(P0[r],dl);P1[r]=fsub_s(P1[r],dl);} \
      _Pragma("unroll") for(int r=0;r<16;++r)negm[r]=-mhat; asm volatile("":"+v"(negm)); } \
    _Pragma("unroll") for(int r=0;r<16;++r)P0[r]=__builtin_amdgcn_exp2f(P0[r]); }while(0)
  #define RESC() do{ if(resc){ asm volatile("s_waitcnt lgkmcnt(0)":::"memory"); \
      _Pragma("unroll") for(int d_=0;d_<2;++d_) _Pragma("unroll") for(int r=0;r<16;++r)o[d_][r]*=wsf[crow(r,hi)]; } }while(0)
  f32x16 pA0,pA1,pB0,pB1;
  int sl_prev=0,sl_cur=0,sl_next=SLOTB;
  #define ROT() do{sl_prev=sl_cur;sl_cur=sl_next;sl_next=(sl_next==(NSLOT-1)*SLOTB)?0:sl_next+SLOTB;}while(0)
  DMA_K(2,2*SLOTB);
  WB3();
  unsigned selmask=0xffffffffu;
  if constexpr(MOBA){
  if(qb<=3) selmask=(1u<<qb)-1u;
  else{ float b1=-INFINITY,b2=-INFINITY,b3=-INFINITY; int i1=0,i2=0,i3=0;
    for(int n=0;n<qb;++n){ float g=0.f;
      _Pragma("unroll") for(int d0=0;d0<4;++d0) _Pragma("unroll") for(int j=0;j<8;++j) g+=__uint_as_float(((unsigned)(unsigned short)qr[d0][j])<<16)*kml[n*64+d0*16+hi*8+j];
      { auto rr=__builtin_amdgcn_permlane32_swap(__float_as_uint(g),__float_as_uint(g),false,false); g=__uint_as_float(rr[0])+__uint_as_float(rr[1]); }
      if(g>b1){b3=b2;i3=i2;b2=b1;i2=i1;b1=g;i1=n;} else if(g>b2){b3=b2;i3=i2;b2=g;i2=n;} else if(g>b3){b3=g;i3=n;} }
    selmask=(1u<<i1)|(1u<<i2)|(1u<<i3); }
  }
  qkt<ND0>(pA0,pA1,Kbase,qr,negm,r32,hi);asm volatile("s_nop 15\n\ts_nop 7":"+v"(pA0),"+v"(pA1));CMASK(pA0,pA1,0);
  START(pA0,pA1);
  _Pragma("unroll") for(int r=0;r<16;++r)pA1[r]=__builtin_amdgcn_exp2f(pA1[r]);
  WAIT_BAR(0);
  DMA_K(3,0);DMA_V(1,SLOTB);
  ROT();
  kloadN<ND0>(kf,kp0+sl_cur);
  WB2();
  s16x4 vlo[8],vhi[8]; u32x4 pw0,pw1,pw2,pw3;
  #define PKW(P,B) cvtpk_s(P[B],P[B+1])
  #define PAF(k) __builtin_bit_cast(bf16x8,pw##k)
  #define VFR(i) (bf16x8){vlo[i][0],vlo[i][1],vlo[i][2],vlo[i][3],vhi[i][0],vhi[i][1],vhi[i][2],vhi[i][3]}
  #define PIN(x) asm volatile("":"+v"(x))
  #define MX3(a,b,c) __builtin_fmaxf(__builtin_fmaxf((a),(b)),(c))
  #define GAPA(MF,A0,A1,A2,A3,W0,W1,PW) do{ MF; sacc+=A0; sacc+=A1; sacc+=A2; sacc+=A3; PIN(sacc); W0; W1; PIN(PW); SBAR(); }while(0)
  #define EX(v) __builtin_amdgcn_exp2f(v)
  #define GAPB(MF,X,B) do{ MF; X[B]=EX(X[B]); X[B+1]=EX(X[B+1]); X[B+2]=EX(X[B+2]); X[B+3]=EX(X[B+3]); PIN(X); SBAR(); }while(0)
  #define VRD(i) do{ vlo[i]=vtr(vp_+(((i)>>2)*4096+((i)&3)*1024)); vhi[i]=vtr(vp_+(((i)>>2)*4096+((i)&3)*1024+512)); }while(0)
  #define KRD(G,j) do{ if(G){ kload2(kf,kp0+sl_next,j); SBAR(); } }while(0)
  #define STEP(C0,C1,P0,P1,t,GK,GV,GL) do{ SBAR(); \
    const lds_cptr vp_=vp0+sl_prev; \
    VRD(0); SBAR(); float sacc=(P0[0]+P0[1]); \
    GAPA(C0=__builtin_amdgcn_mfma_f32_32x32x16_bf16(kf[0],qr[0],negm,0,0,0), P0[2],P0[3],P0[4],P0[5],     pw0[0]=PKW(P0,0), pw0[1]=PKW(P0,2), pw0); \
    VRD(4); SBAR(); GAPA(C1=__builtin_amdgcn_mfma_f32_32x32x16_bf16(kf[1],qr[0],negm,0,0,0), P0[6],P0[7],P0[8],P0[9],     pw0[2]=PKW(P0,4), pw0[3]=PKW(P0,6), pw0); \
    VRD(1); SBAR(); GAPA(C0=__builtin_amdgcn_mfma_f32_32x32x16_bf16(kf[2],qr[1],C0,0,0,0),   P0[10],P0[11],P0[12],P0[13], pw1[0]=PKW(P0,8), pw1[1]=PKW(P0,10), pw1); \
    VRD(5); SBAR(); GAPA(C1=__builtin_amdgcn_mfma_f32_32x32x16_bf16(kf[3],qr[1],C1,0,0,0),   P0[14],P0[15],P1[0],P1[1],   pw1[2]=PKW(P0,12),pw1[3]=PKW(P0,14), pw1); \
    VRD(2); SBAR(); GAPA(C0=__builtin_amdgcn_mfma_f32_32x32x16_bf16(kf[4],qr[2],C0,0,0,0),   P1[2],P1[3],P1[4],P1[5],     pw2[0]=PKW(P1,0), pw2[1]=PKW(P1,2), pw2); \
    VRD(6); SBAR(); GAPA(C1=__builtin_amdgcn_mfma_f32_32x32x16_bf16(kf[5],qr[2],C1,0,0,0),   P1[6],P1[7],P1[8],P1[9],     pw2[2]=PKW(P1,4), pw2[3]=PKW(P1,6), pw2); \
    VRD(3); SBAR(); GAPA(C0=__builtin_amdgcn_mfma_f32_32x32x16_bf16(kf[6],qr[3],C0,0,0,0),   P1[10],P1[11],P1[12],P1[13], pw3[0]=PKW(P1,8), pw3[1]=PKW(P1,10), pw3); \
    VRD(7); SBAR(); GAPA(C1=__builtin_amdgcn_mfma_f32_32x32x16_bf16(kf[7],qr[3],C1,0,0,0),   P1[14],P1[15],0.f,0.f,       pw3[2]=PKW(P1,12),pw3[3]=PKW(P1,14), pw3); \
    if constexpr(ND0==6){ C0=__builtin_amdgcn_mfma_f32_32x32x16_bf16(kf[2*ND0-4],qr[ND0-2],C0,0,0,0); C1=__builtin_amdgcn_mfma_f32_32x32x16_bf16(kf[2*ND0-3],qr[ND0-2],C1,0,0,0); \
      C0=__builtin_amdgcn_mfma_f32_32x32x16_bf16(kf[2*ND0-2],qr[ND0-1],C0,0,0,0); C1=__builtin_amdgcn_mfma_f32_32x32x16_bf16(kf[2*ND0-1],qr[ND0-1],C1,0,0,0); SBAR(); } \
    l_reg+=sacc; \
    if(GK){DMA_K((t)+3,sl_cur);} if(GV){DMA_V((t)+1,sl_next);} \
    CMASK(C0,C1,t); \
    { float a=MX3(C0[0],C0[1],C1[0]),b=MX3(C0[2],C0[3],C1[1]); a=MX3(a,C1[2],C1[3]); \
      _Pragma("unroll") for(int r=4;r<16;r+=4){a=MX3(a,C0[r],C0[r+1]);b=MX3(b,C0[r+2],C0[r+3]);a=MX3(a,C1[r],C1[r+1]);b=MX3(b,C1[r+2],C1[r+3]);} \
      float rm=__builtin_fmaxf(a,b); { auto rr=__builtin_amdgcn_permlane32_swap(__float_as_uint(rm),__float_as_uint(rm),false,false); rm=__builtin_fmaxf(__uint_as_float(rr[0]),__uint_as_float(rr[1])); } \
      resc=false; \
      if(__builtin_expect(__any(rm>(float)THRL),0)){ const float dl=__builtin_fmaxf(rm,0.f); mhat+=dl; \
        _Pragma("unroll") for(int r=0;r<16;++r){C0[r]-=dl;C1[r]-=dl;} \
        _Pragma("unroll") for(int r=0;r<16;++r)negm[r]=-mhat; asm volatile("":"+v"(negm)); \
        const float f=__builtin_amdgcn_exp2f(-dl); l_reg*=f; if(hi==0)wsf[r32]=f; resc=true; } } \
    SBAR(); \
    GAPB(o[0]=__builtin_amdgcn_mfma_f32_32x32x16_bf16(PAF(0),VFR(0),o[0],0,0,0), C0,0); \
    if constexpr(ND0==6){ KRD(GL,ND0-2); } GAPB(o[1]=__builtin_amdgcn_mfma_f32_32x32x16_bf16(PAF(0),VFR(4),o[1],0,0,0), C0,4); \
    KRD(GL,0); GAPB(o[0]=__builtin_amdgcn_mfma_f32_32x32x16_bf16(PAF(1),VFR(1),o[0],0,0,0), C0,8); \
    KRD(GL,1); GAPB(o[1]=__builtin_amdgcn_mfma_f32_32x32x16_bf16(PAF(1),VFR(5),o[1],0,0,0), C0,12); \
    KRD(GL,2); GAPB(o[0]=__builtin_amdgcn_mfma_f32_32x32x16_bf16(PAF(2),VFR(2),o[0],0,0,0), C1,0); \
    KRD(GL,3); GAPB(o[1]=__builtin_amdgcn_mfma_f32_32x32x16_bf16(PAF(2),VFR(6),o[1],0,0,0), C1,4); \
    if constexpr(ND0==6){ KRD(GL,ND0-1); } GAPB(o[0]=__builtin_amdgcn_mfma_f32_32x32x16_bf16(PAF(3),VFR(3),o[0],0,0,0), C1,8); \
    GAPB(o[1]=__builtin_amdgcn_mfma_f32_32x32x16_bf16(PAF(3),VFR(7),o[1],0,0,0), C1,12); \
    }while(0)
  int t=1;
  #undef CMASK
  #define CMASK(P0,P1,t) BMASK(P0,P1,t)
  for(;t+5<NT;t+=2){
    STEP(pB0,pB1,pA0,pA1,t,true,true,true);     WB2(); RESC(); ROT();
    STEP(pA0,pA1,pB0,pB1,t+1,true,true,true);   WB2(); RESC(); ROT();
  }
  #undef CMASK
  #define CMASK(P0,P1,t) do{int jb_=(t)-(NT-4); if(jb_>=0)cmask(P0,P1,jb_,qrel,hi); else BMASK(P0,P1,t);}while(0)
  #define ENDW(tt) do{ if((tt)+3<NT){WB2();} else if((tt)+2<NT){WAIT_BAR(1);} else {WAIT_BAR(0);} }while(0)
  for(;t+1<NT;t+=2){
    STEP(pB0,pB1,pA0,pA1,t,(t+3<NT),(t+1<NT),(t+1<NT));       ENDW(t);   RESC(); ROT();
    STEP(pA0,pA1,pB0,pB1,t+1,(t+4<NT),(t+2<NT),(t+2<NT));     ENDW(t+1); RESC(); ROT();
  }
  STEP(pB0,pB1,pA0,pA1,NT-1,false,false,false); RESC();
  { float sacc=pB0[0]+pB0[1]; _Pragma("unroll") for(int r=2;r<16;++r)sacc+=pB0[r]; _Pragma("unroll") for(int r=0;r<16;++r)sacc+=pB1[r]; l_reg+=sacc;
    pw0=(u32x4){PKW(pB0,0),PKW(pB0,2),PKW(pB0,4),PKW(pB0,6)};pw1=(u32x4){PKW(pB0,8),PKW(pB0,10),PKW(pB0,12),PKW(pB0,14)};pw2=(u32x4){PKW(pB1,0),PKW(pB1,2),PKW(pB1,4),PKW(pB1,6)};pw3=(u32x4){PKW(pB1,8),PKW(pB1,10),PKW(pB1,12),PKW(pB1,14)};
    SBAR(); pv(o,vb0+sl_cur,PAF(0),PAF(1),PAF(2),PAF(3)); }
  #undef PKW
  #undef PAF
  #undef VFR
  #undef PIN
  #undef MX3
  #undef GAPA
  #undef GAPB
  #undef EX
  #undef VRD
  #undef KRD
  #undef STEP
  #undef ENDW
  {auto rr=__builtin_amdgcn_permlane32_swap(__float_as_uint(l_reg),__float_as_uint(l_reg),false,false);l_reg=__uint_as_float(rr[0])+__uint_as_float(rr[1]);}
  if(hi==0)wsf[32+r32]=l_reg;asm volatile("s_waitcnt lgkmcnt(0)":::"memory");
  float rli[16];
  #pragma unroll
  for(int r=0;r<16;++r)rli[r]=__builtin_amdgcn_rcpf(wsf[32+crow(r,hi)]);
  gbf Ow=O+(rowbase+q0+wid*QBLK)*DM+h*D;
  { LAS unsigned short*stg=(LAS unsigned short*)(shm+LDS_OST)+wid*2048;
    #pragma unroll
    for(int r=0;r<16;++r){const int orow=crow(r,hi);
      #pragma unroll
      for(int d0=0;d0<2;++d0)stg[orow*64+d0*32+r32]=(unsigned short)(cvtpk_s(o[d0][r]*rli[r],0.f)&0xffffu);}
    asm volatile("s_waitcnt lgkmcnt(0)":::"memory");
    #pragma unroll
    for(int i=0;i<4;++i){const int row=i*8+(lane>>3),ch=lane&7; const u32x4 v=*(const LAS u32x4*)(stg+row*64+ch*8); *(GAS u32x4*)(Ow+(long)row*DM+ch*8)=v;} }
  asm volatile("s_waitcnt lgkmcnt(0)\n\ts_barrier":::"memory");
  #undef DMA_K
  #undef DMA_V
  #undef WB2
  #undef WB3
  #undef CMASK
  #undef START
  #undef RESC
  #undef ROT
  #undef BMASK
}
#undef SBAR
#undef WAIT_BAR
}

#define XB_TMO      128
#define XB_XCNT(j)  (256  + 64 * (j))
#define XB_XSUB(j)  (1280 + 64 * (j))
#define XB_XGEN(j)  (2304 + 64 * (j))
#define XB_TOP      3328
#define XB_TOPGEN   3392
#define XCD_BAR_WORDS 3456
#define XB_SPIN_CAP (1u << 18)
__device__ __forceinline__ unsigned xb_ld(unsigned* p)              { return __hip_atomic_load(p, __ATOMIC_RELAXED, __HIP_MEMORY_SCOPE_AGENT); }
__device__ __forceinline__ unsigned xb_add(unsigned* p, unsigned v) { return __hip_atomic_fetch_add(p, v, __ATOMIC_RELAXED, __HIP_MEMORY_SCOPE_AGENT); }
__device__ __forceinline__ unsigned xb_xcc_id() { return (unsigned)__builtin_amdgcn_s_getreg((3 << 11) | 20) & 0xFu; }
#define XB_SPIN(cond, bar) do { unsigned _sp = 0; while (cond) { __builtin_amdgcn_s_sleep(1); \
    if ((++_sp & 255u) == 0u) { if (xb_ld(&(bar)[XB_TMO])) break; if (_sp > XB_SPIN_CAP) { atomicAdd(&(bar)[XB_TMO], 1u); break; } } } } while (0)
struct XcdBarrier { unsigned* bar; unsigned x; volatile LAS unsigned* st; };
__device__ __forceinline__ XcdBarrier xcd_barrier_post(unsigned* bar, volatile LAS unsigned* st) {
    XcdBarrier b; b.bar = bar; b.x = xb_xcc_id(); b.st = st;
    if (threadIdx.x == 0) (void)xb_add(&bar[XB_XCNT(b.x)], 1u);
    return b;
}
__device__ __forceinline__ void xcd_barrier_complete(unsigned* bar, unsigned x, unsigned& nloc, unsigned& nx) {
    const unsigned G = gridDim.x * gridDim.y * gridDim.z;
    unsigned sum, cnt, mine, sp = 0u;
    for (;;) {
        sum = 0u; cnt = 0u; mine = 0u;
#pragma unroll
        for (unsigned j = 0; j < 16; ++j) { const unsigned c = xb_ld(&bar[XB_XCNT(j)]); sum += c; cnt += (c > 0u) ? 1u : 0u; mine = (j == x) ? c : mine; }
        if (sum == G) break;
        __builtin_amdgcn_s_sleep(1);
        if ((++sp & 255u) == 0u) { if (xb_ld(&bar[XB_TMO])) break; if (sp > XB_SPIN_CAP) { atomicAdd(&bar[XB_TMO], 1u); break; } }
    }
    nloc = mine > 0u ? mine : 1u; nx = cnt > 0u ? cnt : 1u;
}
__device__ __forceinline__ void xcd_barrier(const XcdBarrier& b, int wave0) {
    asm volatile("s_waitcnt vmcnt(0)" ::: "memory");
    __syncthreads();
    if (phase_tid(wave0) == 0) {
        unsigned* bar = b.bar; asm volatile("" : "+s"(bar));
        __builtin_amdgcn_s_waitcnt(0);
        unsigned nloc = b.st[0], nx = b.st[1];
        unsigned bx = b.x; asm volatile("" : "+s"(bx));
        if (nloc == 0u) { xcd_barrier_complete(bar, bx, nloc, nx); b.st[0] = nloc; b.st[1] = nx; }
        const unsigned old = xb_add(&bar[XB_XSUB(bx)], 1u);
        const unsigned gen = old / nloc;
        if (old + 1u == (gen + 1u) * nloc) {
            __builtin_amdgcn_fence(__ATOMIC_RELEASE, "agent");
            asm volatile("s_waitcnt vmcnt(0)" ::: "memory");
            const unsigned og = xb_add(&bar[XB_TOP], 1u);
            const unsigned tg = og / nx;
            if (og + 1u == (tg + 1u) * nx) xb_add(&bar[XB_TOPGEN], 1u);
            else XB_SPIN(xb_ld(&bar[XB_TOPGEN]) == tg, bar);
            __builtin_amdgcn_fence(__ATOMIC_ACQUIRE, "agent");
            xb_add(&bar[XB_XGEN(bx)], 1u);
            asm volatile("s_waitcnt vmcnt(0)" ::: "memory");
        } else {
            XB_SPIN(xb_ld(&bar[XB_XGEN(bx)]) == gen, bar);
            __builtin_amdgcn_fence(__ATOMIC_ACQUIRE, "agent");
            asm volatile("s_waitcnt vmcnt(0)" ::: "memory");
        }
    }
    __syncthreads();
}

struct Args { const float* in[20]; float* out; unsigned char* ws; int ph_lo, ph_hi; };
struct Frame {
    LAS unsigned char* lds; volatile LAS unsigned* MISC;
    int G, NGW;
    unsigned char* ws;
};
#define PH_IDS const int tid = phase_tid(wave0); const int lane = tid & 63, wave = __builtin_amdgcn_readfirstlane(tid >> 6), gw = (int)blockIdx.x * NWAVES + wave; (void)lane; (void)gw; \
    gws_t ws = (gws_t)args.ws; asm volatile("" : "+s"(ws)); gu32* const ctl = (gu32*)ws; (void)ctl; \
    int bid = (int)blockIdx.x; asm volatile("" : "+s"(bid)); int Gl = F.G; asm volatile("" : "+s"(Gl)); const int NGWl = Gl * NWAVES; (void)NGWl
constexpr int NWAVES = 8;

__device__ __forceinline__ int maprow(int mode, int n) {
    if (mode == 1) {
        if (n >= 2208) return n + 96;
        if (n >= 1024) return n;
        const int reg = n >> 9, o = n & 511, head = o >> 6, dim = o & 63, sg = dim >> 3;
        return reg * 512 + 256 * (head >> 2) + 128 * (sg & 1) + 32 * (head & 3) + 8 * (sg >> 1) + 4 * ((dim >> 2) & 1) + (dim & 3);
    }
    if (mode == 2) { const int nn = n >= DFF ? 1 : 0, a = n - nn * DFF, pn = a >> 7, r = a & 127; return 256 * pn + 128 * nn + r; }
    if (mode == 3) {
        const int h = n >> 7, j = n & 127;
        if (j >= 64) return 512 + h * 64 + (j - 64);
        return 256 * (h >> 2) + 128 * (j >> 5) + 32 * (h & 3) + (j & 31);
    }
    return n;
}
__device__ __forceinline__ void transpose_load(gcf32 W, int N, int nblk, int item, int lane, float* wv) {
    const int kb = item / nblk, nb = item % nblk, k0 = 64 * kb, n0 = 32 * nb;
#pragma unroll
    for (int i = 0; i < 32; ++i) { const int kk = 2 * i + (lane >> 5); wv[i] = W[(size_t)(k0 + kk) * N + n0 + (lane & 31)]; }
}
__device__ __forceinline__ void transpose_store(float* wv, int K, int N, gbf WT, int mode, LAS float* scr, int item, int lane, gcf32 kgain) {
    const int nblk = N / 32, kb = item / nblk, nb = item % nblk, k0 = 64 * kb, n0 = 32 * nb;
    if (kgain) {
#pragma unroll
        for (int i = 0; i < 32; ++i) wv[i] *= kgain[k0 + 2 * i + (lane >> 5)]; }
#pragma unroll
    for (int i = 0; i < 32; ++i) { const int kk = 2 * i + (lane >> 5); scr[kk * 33 + (lane & 31)] = wv[i]; }
    LDS_WAIT(); asm volatile("" ::: "memory");
    const int c = lane & 7;
#pragma unroll
    for (int j = 0; j < 4; ++j) { const int n = (lane >> 3) + 8 * j; const LAS float* s = scr + (8 * c) * 33 + n;
        v4u o; o.x = cvt_pk_bf16(s[0 * 33], s[1 * 33]); o.y = cvt_pk_bf16(s[2 * 33], s[3 * 33]); o.z = cvt_pk_bf16(s[4 * 33], s[5 * 33]); o.w = cvt_pk_bf16(s[6 * 33], s[7 * 33]);
        *(GAS v4u*)(WT + (size_t)maprow(mode, n0 + n) * K + k0 + 8 * c) = o; }
    LDS_WAIT(); asm volatile("" ::: "memory");
}
__device__ __forceinline__ void conv_job(Frame& F, int NGW, int lane, int wave, int gw, gcf32 W, int K, int N, gbf WT, int mode, int& rot, gcf32 kgain = nullptr) {
    LAS float* scr = (LAS float*)(F.lds + wave * 16384);
    const int nitems = (K / 64) * (N / 32);
    int start = gw - rot; if (start < 0) start += NGW;
    const int nblk = N / 32;
    for (int it = start; it < nitems; it += 2 * NGW) {
        const int it2 = it + NGW; const bool two = it2 < nitems;
        float wa[32], wb[32];
        transpose_load(W, N, nblk, it, lane, wa); transpose_load(W, N, nblk, two ? it2 : it, lane, wb);
        transpose_store(wa, K, N, WT, mode, scr, it, lane, kgain);
        if (two) transpose_store(wb, K, N, WT, mode, scr, it2, lane, kgain);
    }
    rot = (rot + nitems) % NGW;
}

__device__ __forceinline__ void unpack8(v4u w, float* f) { f[0] = bf_lo(w.x); f[1] = bf_hi(w.x); f[2] = bf_lo(w.y); f[3] = bf_hi(w.y); f[4] = bf_lo(w.z); f[5] = bf_hi(w.z); f[6] = bf_lo(w.w); f[7] = bf_hi(w.w); }
__device__ __forceinline__ void rms_row_to_bf16(gcf32 xrow, gcf32 g, gbf orow, int lane) {
    const GAS f32x4* xr = (const GAS f32x4*)xrow + lane; const GAS f32x4* gr = (const GAS f32x4*)g + lane;
    f32x4 v[4]; float s = 0.f;
#pragma unroll
    for (int j = 0; j < 4; ++j) { v[j] = xr[64 * j]; s += (v[j].x * v[j].x + v[j].y * v[j].y) + (v[j].z * v[j].z + v[j].w * v[j].w); }
    const float rstd = 1.0f / sqrtf(wave_sum(s, lane) * (1.f / D) + EPS);
    GAS unsigned long long* o8 = (GAS unsigned long long*)orow + lane;
#pragma unroll
    for (int j = 0; j < 4; ++j) { const f32x4 gg = gr[64 * j];
        o8[64 * j] = (unsigned long long)cvt_pk_bf16(v[j].x * rstd * gg.x, v[j].y * rstd * gg.y) | ((unsigned long long)cvt_pk_bf16(v[j].z * rstd * gg.z, v[j].w * rstd * gg.w) << 32); }
}
__device__ __forceinline__ void rms_rows_bf16in(gcbf x, gcf32 g, gbf o, int m0, int ms, int lane) {
    f32x4 gg[2][2];
#pragma unroll
    for (int j = 0; j < 2; ++j) { gg[j][0] = *(const GAS f32x4*)(g + 512 * j + 8 * lane); gg[j][1] = *(const GAS f32x4*)(g + 512 * j + 8 * lane + 4); }
    for (int m = m0; m < M; m += 4 * ms) {
        v4u v[4][2];
#pragma unroll
        for (int r = 0; r < 4; ++r) { const int mr = (m + r * ms < M) ? m + r * ms : m;
#pragma unroll
            for (int j = 0; j < 2; ++j) v[r][j] = *(const GAS v4u*)(x + (size_t)mr * D + 512 * j + 8 * lane); }
#pragma unroll
        for (int r = 0; r < 4; ++r) { const int mr = m + r * ms;
            if (mr < M) { float f[2][8]; float s = 0.f;
#pragma unroll
                for (int j = 0; j < 2; ++j) { unpack8(v[r][j], f[j]);
#pragma unroll
                    for (int e = 0; e < 8; ++e) s += f[j][e] * f[j][e]; }
                const float rstd = 1.0f / sqrtf(wave_sum(s, lane) * (1.f / D) + EPS);
#pragma unroll
                for (int j = 0; j < 2; ++j) { v4u w;
                    w.x = cvt_pk_bf16(f[j][0] * rstd * gg[j][0][0], f[j][1] * rstd * gg[j][0][1]); w.y = cvt_pk_bf16(f[j][2] * rstd * gg[j][0][2], f[j][3] * rstd * gg[j][0][3]);
                    w.z = cvt_pk_bf16(f[j][4] * rstd * gg[j][1][0], f[j][5] * rstd * gg[j][1][1]); w.w = cvt_pk_bf16(f[j][6] * rstd * gg[j][1][2], f[j][7] * rstd * gg[j][1][3]);
                    *(GAS v4u*)(o + (size_t)mr * D + 512 * j + 8 * lane) = w; } } }
    }
}
__device__ __forceinline__ void rms_rows_to_bf16(gcf32 x, gcf32 g, gbf o, int m0, int ms, int lane) {
    const GAS f32x4* gr = (const GAS f32x4*)g + lane; f32x4 gg[4];
#pragma unroll
    for (int j = 0; j < 4; ++j) gg[j] = gr[64 * j];
    for (int m = m0; m < M; m += 4 * ms) {
        f32x4 v[4][4];
#pragma unroll
        for (int r = 0; r < 4; ++r) { const int mr = (m + r * ms < M) ? m + r * ms : m; const GAS f32x4* xr = (const GAS f32x4*)(x + (size_t)mr * D) + lane;
#pragma unroll
            for (int j = 0; j < 4; ++j) v[r][j] = xr[64 * j]; }
#pragma unroll
        for (int r = 0; r < 4; ++r) { const int mr = m + r * ms;
            if (mr < M) {
            float s = 0.f;
#pragma unroll
            for (int j = 0; j < 4; ++j) s += (v[r][j].x * v[r][j].x + v[r][j].y * v[r][j].y) + (v[r][j].z * v[r][j].z + v[r][j].w * v[r][j].w);
            const float rstd = 1.0f / sqrtf(wave_sum(s, lane) * (1.f / D) + EPS);
            GAS unsigned long long* o8 = (GAS unsigned long long*)(o + (size_t)mr * D) + lane;
#pragma unroll
            for (int j = 0; j < 4; ++j)
                o8[64 * j] = (unsigned long long)cvt_pk_bf16(v[r][j].x * rstd * gg[j].x, v[r][j].y * rstd * gg[j].y) | ((unsigned long long)cvt_pk_bf16(v[r][j].z * rstd * gg[j].z, v[r][j].w * rstd * gg[j].w) << 32); } }
    }
}
__device__ __forceinline__ v4u pack8(const float* f) { v4u w; w.x = cvt_pk_bf16(f[0], f[1]); w.y = cvt_pk_bf16(f[2], f[3]); w.z = cvt_pk_bf16(f[4], f[5]); w.w = cvt_pk_bf16(f[6], f[7]); return w; }

constexpr int PH_PER_LAYER = 12, NPH = 1 + 2 * PH_PER_LAYER;

__global__ void __launch_bounds__(NWAVES * 64, 2) mk_fwd(Args args) {
    extern __shared__ __attribute__((aligned(16))) unsigned char lds_raw[];
    Frame F;
    F.lds = (LAS unsigned char*)lds_raw;
    F.MISC = (volatile LAS unsigned*)(F.lds + MISC_OFF);
    F.G = gridDim.x; F.NGW = F.G * NWAVES;
    const int wave0 = __builtin_amdgcn_readfirstlane((int)threadIdx.x >> 6);
    F.ws = args.ws;
    for (int u = threadIdx.x; u < (LDS_BYTES - LDSCTL_OFF) / 4; u += NWAVES * 64) ((LAS unsigned*)(F.lds + LDSCTL_OFF))[u] = 0u;
    __syncthreads();
    XcdBarrier bar = xcd_barrier_post((unsigned*)((gu32*)args.ws + CW_BAR), F.MISC + 8);
    const int lo = args.ph_lo, hi = args.ph_hi;
#define KIN(i) ({ const unsigned char* kp_ = (const unsigned char*)__builtin_amdgcn_kernarg_segment_ptr(); asm volatile("" : "+s"(kp_)); (gcf32)*(const GAS unsigned long long*)(kp_ + 8 * (i)); })
#define RUN(id) ({ int lo_ = lo, hi_ = hi; asm volatile("" : "+s"(lo_), "+s"(hi_)); lo_ <= (id) && (id) < hi_; })
#define SEAM(id) do { int hi_ = hi; asm volatile("" : "+s"(hi_)); if ((id) + 1 < hi_) xcd_barrier(bar, wave0); } while (0)

#define OUT   ((gf32)args.out)
#define HN    ((gbf)args.out)
#define XB    ((gbf)(ws + WS_XB))
#define QA    ((gbf)(ws + WS_QA))
#define KA    ((gbf)(ws + WS_KA))
#define VA    ((gbf)(ws + WS_VA))
#define LAT   ((gbf)(ws + WS_LAT))
#define GATES ((gbf)(ws + WS_GATES))
#define QB    ((gbf)(ws + WS_QB))
#define VB    ((gbf)(ws + WS_KVR))
#define KB    ((gbf)(ws + WS_KB))
#define YB    ((gbf)(ws + WS_YB))
#define YA    ((gbf)(ws + WS_YA))
#define KMEAN ((gf32)(ws + WS_KMEAN))
#define cosA  ((gf32)(ws + WS_ROPE))
#define sinA  (cosA + 4096 * 8)
#define cosB  (sinA + 4096 * 8)
#define sinB  (cosB + 4096 * 16)
#define ELIST ((GAS int*)(ws + WS_ELIST))
#define TOKP  ((gf32)(ws + WS_TOKP))

    if (RUN(0)) {
        PH_IDS;
        int rot = 0;
        for (int l = 0; l < 2; ++l) {
            gws_t wl = ws + WS_WL + l * WL_STRIDE;
            conv_job(F, NGWl, lane, wave, gw, KIN(2) + (size_t)l * D * INW, D, INW, (gbf)(wl + WL_IN), 1, rot);
            conv_job(F, NGWl, lane, wave, gw, KIN(6) + (size_t)l * QRANK * 768, QRANK, 768, (gbf)(wl + WL_UQ), 0, rot, KIN(5) + l * QRANK);
            conv_job(F, NGWl, lane, wave, gw, KIN(8) + (size_t)l * KVRANK * 1024, KVRANK, 1024, (gbf)(wl + WL_UKV), 3, rot, KIN(7) + l * KVRANK);
            conv_job(F, NGWl, lane, wave, gw, KIN(11) + (size_t)l * AW * D, AW, D, (gbf)(wl + WL_BRA), 0, rot);
            conv_job(F, NGWl, lane, wave, gw, KIN(12) + (size_t)l * AW * D, AW, D, (gbf)(wl + WL_BRB), 0, rot);
            conv_job(F, NGWl, lane, wave, gw, KIN(13) + (size_t)l * D * D, D, D, (gbf)(wl + WL_OUT), 0, rot);
            { GAS v4u* z = (GAS v4u*)(wl + WL_IN + (size_t)2208 * D * 2); const int nz = 96 * D * 2 / 16;
              for (int i = bid * 512 + tid; i < nz; i += Gl * 512) z[i] = (v4u){0u, 0u, 0u, 0u}; }
        }
        conv_job(F, NGWl, lane, wave, gw, KIN(15), D, 2 * DFF, (gbf)(ws + WS_WGU), 2, rot);
        conv_job(F, NGWl, lane, wave, gw, KIN(16), DFF, D, (gbf)(ws + WS_WDN), 0, rot);
        { gcf32 g = KIN(1); gcf32 xin = KIN(0);
          rms_rows_to_bf16(xin, g, HN, gw, NGWl, lane); }
        for (int i = bid * 512 + tid; i < 4096 * 24; i += Gl * 512) {
            const int pos = i / 24, j = i % 24;
            if (j < 8) { const float inv = (float)pow(500000.0, -(double)(2 * j) / 16.0); const float ang = (float)pos * inv; cosA[pos * 8 + j] = (float)cos((double)ang); sinA[pos * 8 + j] = (float)sin((double)ang); }
            else { const int jj = j - 8; const float inv = (float)pow(500000.0, -(double)(2 * jj) / 32.0); const float ang = (float)pos * inv; cosB[pos * 16 + jj] = (float)cos((double)ang); sinB[pos * 16 + jj] = (float)sin((double)ang); }
        }
        SEAM(0);
    }

    for (int l = 0; l < 2; ++l) {
        const int pb = 1 + l * PH_PER_LAYER;
#define WLP (ws + WS_WL + (size_t)l * WL_STRIDE)

        if (l == 1 && RUN(pb + 0)) {
            PH_IDS;
            gcf32 g = KIN(1) + l * D;
            rms_rows_bf16in(XB, g, HN, gw, NGWl, lane);
            SEAM(pb + 0);
        }
        if (RUN(pb + 1)) {
            PH_IDS;
            pg8::SchedDense S; S.init_tiles(M / 256, INWP / 256, Gl, bid);
            pg8::EpiInProj E{ws, KIN(3) + l * 64, KIN(4) + l * 64};
            pg8::gemm_phase<pg8::EpiInProj, pg8::SchedDense, true>(wave0, F.lds, HN, D, (gcbf)(WLP + WL_IN), D, 0, D, S, E);
            SEAM(pb + 1);
        }
        if (RUN(pb + 3)) {
            PH_IDS;
            { pg8::SchedDense S; S.init_tiles(M / 256, 3, Gl, bid); pg8::EpiUq E{ws};
              pg8::gemm_phase<pg8::EpiUq, pg8::SchedDense, true>(wave0, F.lds, LAT, LATW, (gcbf)(WLP + WL_UQ), QRANK, 0, QRANK, S, E); }
            { pg8::SchedDense S; S.init_tiles(M / 256, 2, Gl, bid); pg8::EpiUkvK E{ws, KIN(10) + l * 96};
              pg8::gemm_phase<pg8::EpiUkvK, pg8::SchedDense, true>(wave0, F.lds, LAT + QRANK, LATW, (gcbf)(WLP + WL_UKV), KVRANK, 0, KVRANK, S, E); }
            { pg8::SchedDense S; S.init_tiles(M / 256, 2, Gl, bid); pg8::EpiUkvV E{ws};
              pg8::gemm_phase<pg8::EpiUkvV, pg8::SchedDense, true>(wave0, F.lds, LAT + QRANK, LATW, (gcbf)(WLP + WL_UKV) + (size_t)512 * KVRANK, KVRANK, 0, KVRANK, S, E); }
            SEAM(pb + 3);
        }
        if (RUN(pb + 5)) {
            PH_IDS;
            int x = (int)(xb_xcc_id() & 7u), tried = 0;
            for (;;) {
                if (tid == 0) F.MISC[0] = __hip_atomic_fetch_add(ctl + CW_QUEUE + 64 * (l * 8 + x), 1u, RLX_AGENT);
                __syncthreads();
                const int it = __builtin_amdgcn_readfirstlane((int)F.MISC[0]);
                __syncthreads();
                if (it >= 256) { if (++tried == 8) break; x = (x + 1) & 7; continue; }
                const int w = it >> 6, r = it & 63, qb = 15 - (r >> 2), st = r & 3, h = 2 * w + (st & 1), type = st >> 1, b = x;
                if (type == 0) att64::attn_unit<8, 96, false>(wave0, b, h, qb, QB, KB, VB, YB, F.lds, KIN(9) + l * 96, (gcf32)(ws + WS_ROPE) + 2 * 4096 * 8);
                else att64::attn_unit<8, 64, true>(wave0, b, h, qb, QA, KA, VA, YA, F.lds, (gcf32)(ws + WS_KMP) + (size_t)b * 16 * 1024 + h * 64, (gcf32)nullptr);
            }
            SEAM(pb + 5);
        }
        if (RUN(pb + 6)) {
            PH_IDS;
            static_assert(WS_YA - WS_YB == (size_t)32768 * AW * 2 && WL_BRB - WL_BRA == (size_t)D * AW * 2, "chained branch units: ya rows 32768 above yb, W_b right behind W_a");
            { pg8::SchedBranch S; S.init_tiles(M / 256, 4, Gl, bid); pg8::EpiBranch E{HN, (const GAS unsigned char*)(ws + WS_GATES)};
              pg8::gemm_phase<pg8::EpiBranch, pg8::SchedBranch, true>(wave0, F.lds, YB, AW, (gcbf)(WLP + WL_BRA), AW, D, AW, S, E); }
            SEAM(pb + 6);
        }
        if (RUN(pb + 7)) {
            PH_IDS;
            pg8::SchedDense S; S.init_tiles(M / 256, 4, Gl, bid);
            if (l == 0) { pg8::EpiResidB<true> E{(const GAS void*)KIN(0), XB};
                pg8::gemm_phase<pg8::EpiResidB<true>, pg8::SchedDense, true>(wave0, F.lds, HN, D, (gcbf)(WLP + WL_OUT), D, 0, D, S, E); }
            else { pg8::EpiResidB<false> E{(const GAS void*)XB, XB};
                pg8::gemm_phase<pg8::EpiResidB<false>, pg8::SchedDense, true>(wave0, F.lds, HN, D, (gcbf)(WLP + WL_OUT), D, 0, D, S, E); }
            SEAM(pb + 7);
        }
        if (l == 0) {
            if (RUN(pb + 8)) {
            PH_IDS;
                gcf32 g = KIN(14);
                rms_rows_bf16in(XB, g, HN, gw, NGWl, lane);
                SEAM(pb + 8);
            }
            if (RUN(pb + 9)) {
            PH_IDS;
                pg8::SchedDense S; S.init_tiles(M / 256, 22, Gl, bid); pg8::EpiSwiGLU E{(gbf)(ws + WS_ACT0)};
                pg8::gemm_phase<pg8::EpiSwiGLU, pg8::SchedDense, false>(wave0, F.lds, HN, D, (gcbf)(ws + WS_WGU), D, 0, D, S, E);
                SEAM(pb + 9);
            }
            if (RUN(pb + 10)) {
            PH_IDS;
                pg8::SchedDense S; S.init_tiles(M / 256, 4, Gl, bid); pg8::EpiResidB<false> E{(const GAS void*)XB, XB};
                pg8::gemm_phase<pg8::EpiResidB<false>, pg8::SchedDense, true>(wave0, F.lds, (gcbf)(ws + WS_ACT0), DFF, (gcbf)(ws + WS_WDN), DFF, 0, DFF, S, E);
                SEAM(pb + 10);
            }
        } else {
            if (RUN(pb + 8)) {
            PH_IDS;
                gcf32 g = KIN(14) + D; gcf32 rw = KIN(17);
                { GAS v4u* ts = (GAS v4u*)(ws + WS_TAILSLOT); unsigned ff = 0xffffffffu; asm volatile("" : "+v"(ff));
                  for (int i = bid * 512 + tid; i < 2 * M * 4 / 4; i += Gl * 512) ts[i] = (v4u){ff, ff, ff, ff}; }
                int my_e1 = -1, my_e2 = -1, my_tok = -1; float my_p1 = 0.f; int k = 0;
                float rwv[16][8];
#pragma unroll
                for (int j = 0; j < 4; ++j) { const f32x4 gvj = *(const GAS f32x4*)(g + 512 * (j >> 1) + 8 * lane + 4 * (j & 1));
#pragma unroll
                    for (int q = 0; q < 4; ++q) { const int c = 512 * (j >> 1) + 8 * lane + 4 * (j & 1) + q; const f32x4 r0 = *(const GAS f32x4*)(rw + (size_t)c * 8), r1 = *(const GAS f32x4*)(rw + (size_t)c * 8 + 4); const float gg = gvj[q];
                        rwv[4 * j + q][0] = gg * r0.x; rwv[4 * j + q][1] = gg * r0.y; rwv[4 * j + q][2] = gg * r0.z; rwv[4 * j + q][3] = gg * r0.w;
                        rwv[4 * j + q][4] = gg * r1.x; rwv[4 * j + q][5] = gg * r1.y; rwv[4 * j + q][6] = gg * r1.z; rwv[4 * j + q][7] = gg * r1.w; } }
                const int tw = (M + NGWl - 1) / NGWl;
                const int m_lo = gw * tw, m_hi = (m_lo + tw < M) ? m_lo + tw : M;
                for (int m = m_lo; m < m_hi; ++m, ++k) {
                    f32x4 v[4];
#pragma unroll
                    for (int jj = 0; jj < 2; ++jj) { const v4u w = *(const GAS v4u*)(XB + (size_t)m * D + 512 * jj + 8 * lane);
                        v[2 * jj] = (f32x4){bf_lo(w.x), bf_hi(w.x), bf_lo(w.y), bf_hi(w.y)}; v[2 * jj + 1] = (f32x4){bf_lo(w.z), bf_hi(w.z), bf_lo(w.w), bf_hi(w.w)}; }
                    float s = 0.f, lg[8];
#pragma unroll
                    for (int e = 0; e < 8; ++e) lg[e] = 0.f;
#pragma unroll
                    for (int j = 0; j < 4; ++j) { s += (v[j].x * v[j].x + v[j].y * v[j].y) + (v[j].z * v[j].z + v[j].w * v[j].w);
#pragma unroll
                        for (int q = 0; q < 4; ++q)
#pragma unroll
                            for (int e = 0; e < 8; ++e) lg[e] += v[j][q] * rwv[4 * j + q][e]; }
                    const float rstd = 1.0f / sqrtf(wave_sum(s, lane) * (1.f / D) + EPS);
                    float a4[4], b2[2], c1;
                    { const bool up = (lane & 32) != 0;
#pragma unroll
                      for (int i = 0; i < 4; ++i) { const float snd = up ? lg[i] : lg[4 + i], kp = up ? lg[4 + i] : lg[i]; a4[i] = kp + xshfl(snd, 32, lane); } }
                    { const bool up = (lane & 16) != 0;
#pragma unroll
                      for (int i = 0; i < 2; ++i) { const float snd = up ? a4[i] : a4[2 + i], kp = up ? a4[2 + i] : a4[i]; b2[i] = kp + xshfl(snd, 16, lane); } }
                    { const bool up = (lane & 8) != 0; const float snd = up ? b2[0] : b2[1], kp = up ? b2[1] : b2[0]; c1 = kp + xshfl(snd, 8, lane); }
                    c1 += xshfl(c1, 4, lane); c1 += xshfl(c1, 2, lane); c1 += xshfl(c1, 1, lane);
                    float lgs[8];
#pragma unroll
                    for (int e = 0; e < 8; ++e) lgs[e] = rstd * __int_as_float(__builtin_amdgcn_readlane(__float_as_int(c1), 8 * e));
#pragma unroll
                    for (int jj = 0; jj < 2; ++jj) { const f32x4 h0 = v[2 * jj] * rstd * *(const GAS f32x4*)(g + 512 * jj + 8 * lane), h1 = v[2 * jj + 1] * rstd * *(const GAS f32x4*)(g + 512 * jj + 8 * lane + 4);
                        v4u w; w.x = cvt_pk_bf16(h0.x, h0.y); w.y = cvt_pk_bf16(h0.z, h0.w); w.z = cvt_pk_bf16(h1.x, h1.y); w.w = cvt_pk_bf16(h1.z, h1.w);
                        *(GAS v4u*)(HN + (size_t)m * D + 512 * jj + 8 * lane) = w; }
                    float v1 = lgs[0]; int e1 = 0;
#pragma unroll
                    for (int e = 1; e < 8; ++e) if (lgs[e] > v1) { v1 = lgs[e]; e1 = e; }
                    float v2 = -INFINITY; int e2 = 0;
#pragma unroll
                    for (int e = 0; e < 8; ++e) if (e != e1 && lgs[e] > v2) { v2 = lgs[e]; e2 = e; }
                    const float p1 = 1.0f / (1.0f + expf(v2 - v1));
                    if (lane == k) { my_e1 = e1; my_e2 = e2; my_tok = m; my_p1 = p1; }
                }
                GAS int* WCNT = (GAS int*)(ws + WS_WCNT);
                { int myc = 0;
#pragma unroll
                  for (int e = 0; e < 8; ++e) { const int c = __popcll(__ballot(my_e1 == e)) + __popcll(__ballot(my_e2 == e)); if (lane == e) myc = c; }
                  if (lane < 8) WCNT[gw * 8 + lane] = myc; }
                if (my_tok >= 0) { TOKP[my_tok * 2] = my_p1; TOKP[my_tok * 2 + 1] = 1.0f - my_p1; }
                __syncthreads();
                int rot = 0;
                for (int e = 0; e < NEXP; ++e) {
                    conv_job(F, NGWl, lane, wave, gw, KIN(18) + (size_t)e * D * 2 * DFF, D, 2 * DFF, (gbf)(ws + WS_WEGU) + (size_t)e * 2 * DFF * D, 2, rot);
                    conv_job(F, NGWl, lane, wave, gw, KIN(19) + (size_t)e * DFF * D, DFF, D, (gbf)(ws + WS_WEDN) + (size_t)e * D * DFF, 0, rot);
                }
                xcd_barrier(bar, wave0);
                { int pre[8], tot[8];
#pragma unroll
                  for (int e = 0; e < 8; ++e) { pre[e] = 0; tot[e] = 0; }
                  for (int w0 = lane; w0 < NGWl; w0 += 64) { const GAS v4u* cp = (const GAS v4u*)(WCNT + w0 * 8); const v4u c0 = cp[0], c1 = cp[1];
                      const int cc[8] = {(int)c0.x, (int)c0.y, (int)c0.z, (int)c0.w, (int)c1.x, (int)c1.y, (int)c1.z, (int)c1.w};
#pragma unroll
                      for (int e = 0; e < 8; ++e) { tot[e] += cc[e]; if (w0 < gw) pre[e] += cc[e]; } }
#pragma unroll
                  for (int e = 0; e < 8; ++e) {
#pragma unroll
                      for (int o = 1; o < 64; o <<= 1) { pre[e] += __builtin_amdgcn_ds_bpermute((lane ^ o) << 2, pre[e]); tot[e] += __builtin_amdgcn_ds_bpermute((lane ^ o) << 2, tot[e]); } }
                  const unsigned long long below = (1ull << lane) - 1ull;
#pragma unroll
                  for (int e = 0; e < 8; ++e) { const unsigned long long m1 = __ballot(my_e1 == e), m2 = __ballot(my_e2 == e); const int c1 = __popcll(m1);
                      if (my_e1 == e) ELIST[e * 32768 + pre[e] + __popcll(m1 & below)] = my_tok * 2;
                      if (my_e2 == e) ELIST[e * 32768 + pre[e] + c1 + __popcll(m2 & below)] = my_tok * 2 + 1;
                      if (gw == 0 && lane == 0) __hip_atomic_store(ctl + CW_ECNT + 64 * e, (unsigned)tot[e], RLX_AGENT); } }
                SEAM(pb + 8);
            }
            if (RUN(pb + 9) || RUN(pb + 10)) {
                PH_IDS;
                if (tid == 0) { int off = 0;
                    for (int e = 0; e < 8; ++e) { const int c = (int)__hip_atomic_load(ctl + CW_ECNT + 64 * e, RLX_AGENT); F.MISC[16 + e] = (unsigned)off; F.MISC[32 + e] = (unsigned)c; off += (c + 255) >> 8; }
                    F.MISC[24] = (unsigned)off; }
                __syncthreads();
            }
            const volatile LAS int* tab = (const volatile LAS int*)(F.MISC + 16);
            if (RUN(pb + 9)) {
            PH_IDS;
                pg8::SchedMoe S; S.init_tiles(__builtin_amdgcn_readfirstlane(tab[8]), 22, Gl, bid); S.tab = tab; S.list = ELIST; S.gather = 1;
                pg8::EpiSwiGLU E{(gbf)(ws + WS_ACT1)};
                pg8::gemm_phase<pg8::EpiSwiGLU, pg8::SchedMoe, false>(wave0, F.lds, HN, D, (gcbf)(ws + WS_WEGU), D, 2 * DFF, D, S, E);
                SEAM(pb + 9);
            }
            if (RUN(pb + 10)) {
            PH_IDS;
                static_assert(DFF / 64 == pg8::KPARTS * pg8::KPART_TILES, "K-split of the down-projection");
                pg8::SchedMoeK S; S.init_tiles(__builtin_amdgcn_readfirstlane(tab[8]), 4, Gl, bid); S.tab = tab; S.init_split();
                pg8::EpiMoeDown E{(gbf)(ws + WS_Y), tab, ELIST, TOKP, (gbf)(ws + WS_KPART), (GAS int*)(ws + WS_TAILSLOT)};
                pg8::gemm_phase<pg8::EpiMoeDown, pg8::SchedMoeK, true>(wave0, F.lds, (gcbf)(ws + WS_ACT1), DFF, (gcbf)(ws + WS_WEDN), DFF, D, DFF, S, E);
                SEAM(pb + 10);
            }
            if (RUN(pb + 11)) {
            PH_IDS;
                gcbf Y0 = (gcbf)(ws + WS_Y); gcbf Y1 = Y0 + (size_t)M * D; gcbf KP = (gcbf)(ws + WS_KPART); const GAS int* tsl = (const GAS int*)(ws + WS_TAILSLOT);
                constexpr int kparts = pg8::KPARTS;
                const unsigned bad = __hip_atomic_load((gu32*)(ctl + CW_BAR + XB_TMO), RLX_AGENT);
                const size_t n8 = (size_t)M * D / 8;
                for (size_t i = (size_t)bid * 512 + tid; i < n8; i += (size_t)Gl * 512) {
                    const size_t tok = i >> 7; const int pn = (int)(i & 127) >> 5, cin = ((int)i & 31) * 8;
                    const int t0 = tsl[tok * 4 + pn], t1 = tsl[((size_t)M + tok) * 4 + pn];
                    float a[8], c[8]; unpack8(*(const GAS v4u*)(Y0 + i * 8), a); unpack8(*(const GAS v4u*)(Y1 + i * 8), c);
                    if (t0 >= 0) { gcbf ps = KP + (size_t)(t0 >> 8) * 65536 + (t0 & 255) * 256 + cin;
#pragma unroll
                        for (int e = 0; e < 8; ++e) a[e] = 0.f;
                        for (int sp = 0; sp < kparts; ++sp) { float q[8]; unpack8(*(const GAS v4u*)(ps + (size_t)sp * 65536), q);
#pragma unroll
                            for (int e = 0; e < 8; ++e) a[e] += q[e]; } }
                    if (t1 >= 0) { gcbf ps = KP + (size_t)(t1 >> 8) * 65536 + (t1 & 255) * 256 + cin;
#pragma unroll
                        for (int e = 0; e < 8; ++e) c[e] = 0.f;
                        for (int sp = 0; sp < kparts; ++sp) { float q[8]; unpack8(*(const GAS v4u*)(ps + (size_t)sp * 65536), q);
#pragma unroll
                            for (int e = 0; e < 8; ++e) c[e] += q[e]; } }
                    float xs[8]; unpack8(*(const GAS v4u*)(XB + i * 8), xs);
                    f32x4 x0 = (f32x4){xs[0], xs[1], xs[2], xs[3]}, x1 = (f32x4){xs[4], xs[5], xs[6], xs[7]};
                    x0.x += a[0] + c[0]; x0.y += a[1] + c[1]; x0.z += a[2] + c[2]; x0.w += a[3] + c[3];
                    x1.x += a[4] + c[4]; x1.y += a[5] + c[5]; x1.z += a[6] + c[6]; x1.w += a[7] + c[7];
                    if (bad) { const float q = __builtin_nanf(""); x0 = (f32x4){q, q, q, q}; x1 = x0; }
                    *(GAS f32x4*)(OUT + i * 8) = x0; *(GAS f32x4*)(OUT + i * 8 + 4) = x1;
                }
            }
        }
    }
#undef RUN
#undef SEAM
}

extern "C" void kernel_launch(void* const* d_in, const int* in_sizes, int n_in, void* d_out, int out_size, void* d_ws, size_t ws_size, hipStream_t stream) {
    static int grid = 0;
    if (grid == 0) {
        if (n_in != 20 || out_size != M * D || ws_size < WS_END) { fprintf(stderr, "kernel_launch: unexpected sizes n_in %d out %d ws %zu (need %zu)\n", n_in, out_size, ws_size, (size_t)WS_END); grid = -1; return; }
        int dev = 0, cus = 0, per_cu = 0;
        if (hipGetDevice(&dev) != hipSuccess || hipDeviceGetAttribute(&cus, hipDeviceAttributeMultiprocessorCount, dev) != hipSuccess) { grid = -1; return; }
        if (hipFuncSetAttribute((const void*)mk_fwd, hipFuncAttributeMaxDynamicSharedMemorySize, LDS_BYTES) != hipSuccess) { fprintf(stderr, "kernel_launch: hipFuncSetAttribute failed\n"); grid = -1; return; }
        if (hipOccupancyMaxActiveBlocksPerMultiprocessor(&per_cu, (const void*)mk_fwd, NWAVES * 64, LDS_BYTES) != hipSuccess || per_cu < 1) fprintf(stderr, "kernel_launch: occupancy query says %d\n", per_cu);
        (void)hipGetLastError();
        grid = cus;
    }
    if (grid < 0) return;
    if (hipMemsetAsync((char*)d_ws + WS_CTL, 0, CTL_ZERO_BYTES, stream) != hipSuccess) return;
    Args a{};
    for (int i = 0; i < 20; ++i) a.in[i] = (const float*)d_in[i];
    a.out = (float*)d_out; a.ws = (unsigned char*)d_ws;
#if MK_SPLIT
    for (int p = 0; p < NPH; ++p) { a.ph_lo = p; a.ph_hi = p + 1; hipLaunchKernelGGL(mk_fwd, dim3(grid), dim3(NWAVES * 64), LDS_BYTES, stream, a); }
#else
    a.ph_lo = 0; a.ph_hi = NPH;
    hipLaunchKernelGGL(mk_fwd, dim3(grid), dim3(NWAVES * 64), LDS_BYTES, stream, a);
#endif
}
```

```cpp
#include <hip/hip_runtime.h>
#include <hip/hip_bf16.h>
#include <cstdio>
#include <cstdint>

#ifndef MK_SPLIT
#define MK_SPLIT 0
#endif

constexpr int BATCH = 8, SEQ = 4096, D = 1024, M = BATCH * SEQ;
constexpr int AW = 512;
constexpr int QRANK = 384, KVRANK = 256;
constexpr int INW = 4256, INWP = 4352;
constexpr int LATW = 768;
constexpr int DFF = 2816, NEXP = 8;
constexpr int MOE_TILES_MAX = 264;
constexpr float EPS = 1e-6f;
constexpr float LOG2E = 1.4426950408889634f;
constexpr float C2A = 0.125f * LOG2E;
constexpr float C2B = 0.10206207261596575f * LOG2E;

constexpr size_t MiB = 1u << 20;
constexpr size_t WS_CTL = 0, CTL_ZERO_BYTES = 1 * MiB;
constexpr size_t WS_KMEAN = 1 * MiB;
constexpr size_t WS_ROPE = 1 * MiB + 512 * 1024;
constexpr size_t WS_ELIST = 3 * MiB;
constexpr size_t WS_TOKP = 4 * MiB;
constexpr size_t WS_WCNT = 4 * MiB + 512 * 1024;
constexpr size_t WS_SSLAT = 5 * MiB;
constexpr size_t WS_KMP = 8 * MiB;
constexpr size_t WS_WL = 16 * MiB, WL_STRIDE = 14 * MiB;
constexpr size_t WL_IN = 0, WL_UQ = WL_IN + (size_t)INWP * D * 2, WL_UKV = WL_UQ + (size_t)768 * QRANK * 2, WL_BRA = WL_UKV + (size_t)1024 * KVRANK * 2,
                 WL_BRB = WL_BRA + (size_t)D * AW * 2, WL_OUT = WL_BRB + (size_t)D * AW * 2, WL_END = WL_OUT + (size_t)D * D * 2;
static_assert(WL_END <= WL_STRIDE, "per-layer weights");
constexpr size_t WS_WGU = 44 * MiB, WS_WDN = 55 * MiB;
constexpr size_t WS_XB = 64 * MiB;
constexpr size_t WS_QA = 128 * MiB, WS_KA = 160 * MiB, WS_VA = 192 * MiB;
constexpr size_t WS_LAT = 224 * MiB, WS_GATES = 272 * MiB, WS_QB = 400 * MiB, WS_KVR = 448 * MiB, WS_KB = 512 * MiB, WS_YB = 560 * MiB, WS_YA = 592 * MiB;
constexpr size_t WS_ACT0 = 128 * MiB;
constexpr size_t WS_Y = 128 * MiB;
constexpr size_t WS_WEGU = 192 * MiB, WS_WEDN = 280 * MiB;
constexpr size_t WS_ACT1 = 324 * MiB;
constexpr size_t WS_END = 688 * MiB;
static_assert(WS_ACT1 + (size_t)MOE_TILES_MAX * 256 * DFF * 2 <= WS_END, "ws map");

constexpr int CW_TMO = 0, CW_BAR = 4096, CW_QUEUE = 8192  , CW_ECNT = 10240;

constexpr int RING_BYTES = 131072, LDSCTL_OFF = RING_BYTES, MISC_OFF = LDSCTL_OFF + 320, LDS_BYTES = 147456;

#define GAS __attribute__((address_space(1)))
#define LAS __attribute__((address_space(3)))
typedef unsigned short bf16;
typedef unsigned v4u __attribute__((ext_vector_type(4)));
typedef unsigned v2u __attribute__((ext_vector_type(2)));
typedef float f32x4 __attribute__((ext_vector_type(4)));
typedef float f32x16 __attribute__((ext_vector_type(16)));
typedef short bf16x8 __attribute__((ext_vector_type(8)));
typedef short s16x4 __attribute__((ext_vector_type(4)));
typedef GAS unsigned gu32;
typedef GAS unsigned char* gws_t;
typedef GAS unsigned short* gbf;
typedef const GAS unsigned short* gcbf;
typedef GAS float* gf32;
typedef const GAS float* gcf32;
#define RLX_AGENT __ATOMIC_RELAXED, __HIP_MEMORY_SCOPE_AGENT
#define LDS_WAIT() asm volatile("s_waitcnt lgkmcnt(0)" ::: "memory")
#define VM_WAIT() asm volatile("s_waitcnt vmcnt(0)" ::: "memory")

__device__ __forceinline__ unsigned cvt_pk_bf16(float lo, float hi) { unsigned r; asm volatile("v_cvt_pk_bf16_f32 %0, %1, %2" : "=v"(r) : "v"(lo), "v"(hi)); return r; }
__device__ __forceinline__ float bf_lo(unsigned w) { return __uint_as_float(w << 16); }
__device__ __forceinline__ float bf_hi(unsigned w) { return __uint_as_float(w & 0xffff0000u); }
__device__ __forceinline__ int fresh_lane() { unsigned z = 0u; asm volatile("" : "+v"(z)); return (int)__builtin_amdgcn_mbcnt_hi(~0u, __builtin_amdgcn_mbcnt_lo(~0u, z)); }
__device__ __forceinline__ int phase_tid(int wave0) { unsigned z = 0u; asm volatile("" : "+v"(z)); return wave0 * 64 + (int)__builtin_amdgcn_mbcnt_hi(~0u, __builtin_amdgcn_mbcnt_lo(~0u, z)); }
__device__ __forceinline__ float xshfl(float v, int m, int lane) { return __int_as_float(__builtin_amdgcn_ds_bpermute((lane ^ m) << 2, __float_as_int(v))); }
__device__ __forceinline__ float wave_sum(float v, int lane) {
#pragma unroll
    for (int o = 1; o < 64; o <<= 1) v += xshfl(v, o, lane);
    return v;
}
__device__ __forceinline__ float fast_sigmoid(float x) { return __builtin_amdgcn_rcpf(1.0f + __builtin_amdgcn_exp2f(-x * LOG2E)); }

namespace pg8 {
#define PG8_LAS __attribute__((address_space(3)))
typedef unsigned short bf16_t;
constexpr int BM = 256, BK = 64, HALF = 128, HTB = HALF * BK * 2, STAGE_BYTES = 8 * HTB, NXCD = 8, WGM = 8;
__host__ __device__ __forceinline__ int lds_byte(int r, int c) { const int st = (r >> 4) * 2 + (c >> 5), rr = r & 15, cc = c & 31, ob = rr * 64 + cc * 2; return st * 1024 + (ob ^ (((ob >> 9) & 1) << 5)); }
__host__ __device__ __forceinline__ void stage_rc(int b, int& R, int& C) { const int st = b / 1024, sb = b % 1024, swz = sb ^ (((sb >> 9) & 1) << 5); R = (st >> 1) * 16 + swz / 64; C = (st & 1) * 32 + (swz % 64) / 2; }
__host__ __device__ __forceinline__ int perm32(int rho) { const int n = rho >> 4, i = rho & 15; return 8 * (i >> 2) + 4 * n + (i & 3); }

struct Unit { int pm, pn, e; };

struct OrderBase {
    int nM, nN, nwg, G, c;
    __device__ __forceinline__ void init_tiles(int nM_, int nN_, int G_, int c_) { nM = nM_; nN = nN_; nwg = nM * nN; G = G_; c = c_; }
    __device__ __forceinline__ bool next_tile(int i, Unit& u) const {
        const long L = (long)i * G + c; if (L >= nwg) return false;
        int wgid = (int)L; { const int q = nwg / NXCD, r = nwg % NXCD, xcd = wgid % NXCD, off = wgid / NXCD; wgid = (xcd < r ? xcd * (q + 1) : r * (q + 1) + (xcd - r) * q) + off; }
        const int nig = WGM * nN, gid = wgid / nig, fm = gid * WGM, gsz = (nM - fm) < WGM ? (nM - fm) : WGM;
        u.pm = fm + ((wgid % nig) % gsz); u.pn = (wgid % nig) / gsz; u.e = 0; return true;
    }
};
struct SchedDense : OrderBase {
    static constexpr bool EARLY_ROWS = false;
    __device__ __forceinline__ bool next(int i, Unit& u) const { return next_tile(i, u); }
    __device__ __forceinline__ int arow(const Unit& u, int r) const { return u.pm * BM + r; }
};
struct SchedBranch : OrderBase {
    static constexpr bool EARLY_ROWS = false;
    __device__ __forceinline__ bool next(int i, Unit& u) const { if (!next_tile(i >> 1, u)) return false; u.e = i & 1; return true; }
    __device__ __forceinline__ int arow(const Unit& u, int r) const { return u.pm * BM + r + (u.e == 0 ? 32768 : 0); }
};
struct SchedMoe : OrderBase {
    static constexpr bool EARLY_ROWS = true;
    const volatile PG8_LAS int* tab; const GAS int* list; int gather;
    __device__ __forceinline__ bool next(int i, Unit& u) const {
        if (!next_tile(i, u)) return false;
        int e = 0;
#pragma unroll
        for (int k = 1; k < 8; ++k) e += (u.pm >= tab[k]) ? 1 : 0;
        u.e = __builtin_amdgcn_readfirstlane(e); return true;
    }
    __device__ __forceinline__ int arow(const Unit& u, int r) const {
        if (!gather) return u.pm * BM + r;
        const int pos = (u.pm - tab[u.e]) * BM + r;
        return pos < tab[16 + u.e] ? (list[u.e * 32768 + pos] >> 1) : 0;
    }
};

template <class Epi, class Sched, bool ALIGN_EPI>
__device__ __forceinline__ void gemm_phase(int wave0, PG8_LAS unsigned char* lds, gcbf Ag, int lda, gcbf Bg, int ldb, int browsE, int K, const Sched& S, const Epi& E) {
    const int tid = phase_tid(wave0);
    const int wid = __builtin_amdgcn_readfirstlane(tid >> 6), lane = tid & 63, wr = wid >> 2, wc = wid & 3, fr = lane & 15, fq = lane >> 4;
    const int nt = K / BK;
    unsigned voffB[2];
#pragma unroll
    for (int i = 0; i < 2; ++i) { int R, C; stage_rc(tid * 16 + i * 8192, R, C); const int Rb = Epi::PERM ? ((R & ~31) + perm32(R & 31)) : R;
        voffB[i] = (unsigned)(Rb * ldb + C) * 2u; }
#define PG8_AOFFS(dst, unit) do { const int t_ = phase_tid(wave0); _Pragma("unroll") for (int i = 0; i < 2; ++i) { int R, C; stage_rc(t_ * 16 + i * 8192, R, C); \
        _Pragma("unroll") for (int h = 0; h < 2; ++h) dst[h][i] = (unsigned)S.arow(unit, h * HALF + R) * lda2 + (unsigned)C * 2u; } } while (0)
#define PG8_AROWS(dst, unit) do { const int t_ = phase_tid(wave0); _Pragma("unroll") for (int i = 0; i < 2; ++i) { int R, C; stage_rc(t_ * 16 + i * 8192, R, C); \
        _Pragma("unroll") for (int h = 0; h < 2; ++h) dst[h][i] = S.arow(unit, h * HALF + R); } } while (0)
#define PG8_AOFFS_R(dst, rows) do { const int t_ = phase_tid(wave0); _Pragma("unroll") for (int i = 0; i < 2; ++i) { int R, C; stage_rc(t_ * 16 + i * 8192, R, C); \
        _Pragma("unroll") for (int h = 0; h < 2; ++h) dst[h][i] = (unsigned)rows[h][i] * lda2 + (unsigned)C * 2u; } } while (0)
    const size_t kstep = (size_t)(BK * 2);
    const size_t hstepB = (size_t)HALF * ldb * 2;
    const unsigned lda2 = (unsigned)lda * 2u;
    const unsigned ldsw = (unsigned)wid * 1024u;
    const int aoff = lds_byte(wr * 64 + fr, fq * 8), boff = lds_byte(wc * 32 + fr, fq * 8);
    const GAS char* Abase = (const GAS char*)Ag;
#define PG8_SA(b, h) (((b) * 2 + (h)) * HTB)
#define PG8_SB(b, h) ((4 + (b) * 2 + (h)) * HTB)
#define PG8_STAGEB(bufoff, gbase) do { _Pragma("unroll") for (int _i = 0; _i < 2; ++_i) \
        __builtin_amdgcn_global_load_lds((const GAS unsigned*)((gbase) + voffB[_i]), (PG8_LAS unsigned*)(lds + (bufoff) + ldsw + _i * 8192), 16, 0, 0); } while (0)
#define PG8_STAGEA(bufoff, kb, VO, h) do { _Pragma("unroll") for (int _i = 0; _i < 2; ++_i) \
        __builtin_amdgcn_global_load_lds((const GAS unsigned*)(Abase + (kb) + (VO)[h][_i]), (PG8_LAS unsigned*)(lds + (bufoff) + ldsw + _i * 8192), 16, 0, 0); } while (0)
#define PG8_LDA(dst, b, h) do { _Pragma("unroll") for (int m = 0; m < 4; ++m) _Pragma("unroll") for (int k = 0; k < 2; ++k) dst[m][k] = *(const PG8_LAS bf16x8*)(lds + PG8_SA(b, h) + aoff + m * 2048 + k * 1024); } while (0)
#define PG8_LDB(dst, b, h) do { _Pragma("unroll") for (int n = 0; n < 2; ++n) _Pragma("unroll") for (int k = 0; k < 2; ++k) dst[n][k] = *(const PG8_LAS bf16x8*)(lds + PG8_SB(b, h) + boff + n * 2048 + k * 1024); } while (0)
#define PG8_MMA(ai, bj, At, Bt) do { __builtin_amdgcn_s_setprio(1); _Pragma("unroll") for (int m = 0; m < 4; ++m) _Pragma("unroll") for (int n = 0; n < 2; ++n) _Pragma("unroll") for (int k = 0; k < 2; ++k) \
        acc[ai][bj][m][n] = __builtin_amdgcn_mfma_f32_16x16x32_bf16(Bt[n][k], At[m][k], acc[ai][bj][m][n], 0, 0, 0); __builtin_amdgcn_s_setprio(0); } while (0)
#define PG8_WAIT_V(n) asm volatile("s_waitcnt vmcnt(" #n ")" ::: "memory")
#define PG8_WAIT_L(n) asm volatile("s_waitcnt lgkmcnt(" #n ")" ::: "memory")
#define PG8_BAR __builtin_amdgcn_s_barrier()
#define PG8_SCHED __builtin_amdgcn_sched_barrier(0)
    Unit cur, nxt; int ui = 0;
    if (!S.next(0, cur)) return;
    PG8_LAS unsigned* const stash0 = (PG8_LAS unsigned*)(lds + STAGE_BYTES + 1024);
    E.stash(cur, tid, stash0);
    f32x4 acc[2][2][4][2];
#pragma unroll
    for (int a = 0; a < 2; ++a)
#pragma unroll
        for (int b = 0; b < 2; ++b)
#pragma unroll
            for (int m = 0; m < 4; ++m)
#pragma unroll
                for (int n = 0; n < 2; ++n) acc[a][b][m][n] = (f32x4){0.f, 0.f, 0.f, 0.f};
    bf16x8 At[4][2], B0[2][2], B1[2][2];
    unsigned vA[2][2];
    PG8_AOFFS(vA, cur);
    const GAS char* cB = (const GAS char*)Bg + ((size_t)cur.e * browsE + (size_t)cur.pn * BM) * ldb * 2;
    PG8_STAGEB(PG8_SB(0, 0), cB); PG8_STAGEB(PG8_SB(0, 1), cB + hstepB); PG8_STAGEA(PG8_SA(0, 0), 0, vA, 0); PG8_STAGEA(PG8_SA(0, 1), 0, vA, 1);
    if (wr == 1) PG8_BAR;
    PG8_WAIT_V(2); PG8_BAR;
    PG8_STAGEB(PG8_SB(1, 0), cB + kstep); PG8_STAGEA(PG8_SA(1, 0), kstep, vA, 0); PG8_STAGEB(PG8_SB(1, 1), cB + hstepB + kstep);
    PG8_WAIT_V(6); PG8_BAR;
    for (;;) {
        const bool has_next = S.next(ui + 1, nxt);
        if (!has_next) nxt = cur;
        int nrows[2][2];
        if constexpr (Sched::EARLY_ROWS) { PG8_AROWS(nrows, nxt); }
        const GAS char* nB = (const GAS char*)Bg + ((size_t)nxt.e * browsE + (size_t)nxt.pn * BM) * ldb * 2;
        for (int t = 0; t < nt; t += 2) {
            const bool last = (t == nt - 2);
            const size_t ka1 = (size_t)(t + 1) * kstep;
            const size_t ka2 = last ? (size_t)0 : (size_t)(t + 2) * kstep; const GAS char* b2 = last ? nB : cB + (size_t)(t + 2) * kstep;
            const size_t ka3 = ka2 + kstep; const GAS char* b3 = b2 + kstep;
            unsigned sA[2][2];
            if (last) { if constexpr (Sched::EARLY_ROWS) { PG8_AOFFS_R(sA, nrows); } else { PG8_AOFFS(sA, nxt); } }
            else {
#pragma unroll
                for (int h = 0; h < 2; ++h)
#pragma unroll
                    for (int i = 0; i < 2; ++i) sA[h][i] = vA[h][i]; }
            PG8_LDB(B0, 0, 0); PG8_LDB(B1, 0, 1); PG8_SCHED; PG8_LDA(At, 0, 0); PG8_STAGEA(PG8_SA(1, 1), ka1, vA, 1);
            PG8_WAIT_V(8); PG8_WAIT_L(0); PG8_BAR; PG8_MMA(0, 0, At, B0); PG8_MMA(0, 1, At, B1); PG8_BAR; PG8_SCHED;
            PG8_LDA(At, 0, 1); PG8_STAGEB(PG8_SB(0, 0), b2); PG8_STAGEB(PG8_SB(0, 1), b2 + hstepB); PG8_STAGEA(PG8_SA(0, 0), ka2, sA, 0);
            PG8_WAIT_V(8); PG8_WAIT_L(0); PG8_BAR; PG8_MMA(1, 0, At, B0); PG8_MMA(1, 1, At, B1); PG8_BAR; PG8_SCHED;
            PG8_LDB(B0, 1, 0); PG8_LDB(B1, 1, 1); PG8_SCHED; PG8_LDA(At, 1, 0); PG8_STAGEA(PG8_SA(0, 1), ka2, sA, 1);
            PG8_WAIT_V(8); PG8_WAIT_L(0); PG8_BAR; PG8_MMA(0, 0, At, B0); PG8_MMA(0, 1, At, B1); PG8_BAR; PG8_SCHED;
            PG8_LDA(At, 1, 1); PG8_STAGEB(PG8_SB(1, 0), b3); PG8_STAGEB(PG8_SB(1, 1), b3 + hstepB); PG8_STAGEA(PG8_SA(1, 0), ka3, sA, 0);
            PG8_WAIT_V(8); PG8_WAIT_L(0); PG8_BAR; PG8_MMA(1, 0, At, B0); PG8_MMA(1, 1, At, B1); PG8_BAR; PG8_SCHED;
        }
        if constexpr (ALIGN_EPI) { if (wr == 0) PG8_BAR; }
        E(acc, cur, wr, wc, stash0 + (ui & 1) * 1024);
        if (!has_next) break;
        if (!Epi::chained(cur)) {
#pragma unroll
        for (int a = 0; a < 2; ++a)
#pragma unroll
            for (int b = 0; b < 2; ++b)
#pragma unroll
                for (int m = 0; m < 4; ++m)
#pragma unroll
                    for (int n = 0; n < 2; ++n) acc[a][b][m][n] = (f32x4){0.f, 0.f, 0.f, 0.f};
        }
        cur = nxt; cB = nB; ++ui;
        E.stash(cur, phase_tid(wave0), stash0 + (ui & 1) * 1024);
        if constexpr (Sched::EARLY_ROWS) { PG8_AOFFS_R(vA, nrows); } else { PG8_AOFFS(vA, cur); }
        if constexpr (ALIGN_EPI) { if (wr == 1) PG8_BAR; }
    }
    PG8_WAIT_V(0);
    if constexpr (!ALIGN_EPI) { if (wr == 0) PG8_BAR; }
    PG8_BAR;
#undef PG8_SA
#undef PG8_SB
#undef PG8_STAGEA
#undef PG8_AOFFS
#undef PG8_AROWS
#undef PG8_AOFFS_R
#undef PG8_STAGEB
#undef PG8_LDA
#undef PG8_LDB
#undef PG8_MMA
#undef PG8_WAIT_V
#undef PG8_WAIT_L
#undef PG8_BAR
#undef PG8_SCHED
}

typedef f32x4 Acc[2][2][4][2];

struct EpiInProj {
    static constexpr bool PERM = true; static __device__ __forceinline__ bool chained(const Unit&) { return false; } __device__ __forceinline__ void stash(const Unit&, int, PG8_LAS unsigned*) const {}
    gws_t ws; gcf32 gq, gk;
    __device__ __forceinline__ void operator()(Acc& acc, const Unit& u, int wr, int wc, const PG8_LAS unsigned* st) const {
        const int ln_ = fresh_lane(), fr = ln_ & 15, fq = ln_ >> 4;
        const int lane = fq * 16 + fr;
        if (u.pn < 4) {
            const bool isK = u.pn >= 2; const int head = 4 * (u.pn & 1) + wc;
            gcf32 gp = isK ? gk : gq; gbf base = (gbf)(ws + (isK ? WS_KA : WS_QA)); gcf32 ct = (gcf32)(ws + WS_ROPE), st = ct + 4096 * 8;
            f32x4 g[2][2];
#pragma unroll
            for (int bj = 0; bj < 2; ++bj)
#pragma unroll
                for (int n = 0; n < 2; ++n) g[bj][n] = *(const GAS f32x4*)(gp + 8 * (2 * fq + bj) + 4 * n);
            f32x4 ks[2][2];
#pragma unroll
            for (int bj = 0; bj < 2; ++bj)
#pragma unroll
                for (int n = 0; n < 2; ++n) ks[bj][n] = (f32x4){0.f, 0.f, 0.f, 0.f};
            const int row0 = u.pm * BM + wr * 64 + fr;
#pragma unroll
            for (int ai = 0; ai < 2; ++ai)
#pragma unroll
                for (int m = 0; m < 4; ++m) { const int row = row0 + ai * HALF + m * 16, pos = row & (SEQ - 1);
                    f32x4 y[2][2]; float ss = 0.f;
#pragma unroll
                    for (int bj = 0; bj < 2; ++bj)
#pragma unroll
                        for (int n = 0; n < 2; ++n) { y[bj][n] = acc[ai][bj][m][n]; ss += (y[bj][n][0] * y[bj][n][0] + y[bj][n][1] * y[bj][n][1]) + (y[bj][n][2] * y[bj][n][2] + y[bj][n][3] * y[bj][n][3]); }
                    ss += xshfl(ss, 16, lane); ss += xshfl(ss, 32, lane);
                    const float rstd = 1.0f / sqrtf(ss * (1.f / 64.f) + EPS);
#pragma unroll
                    for (int bj = 0; bj < 2; ++bj)
#pragma unroll
                        for (int n = 0; n < 2; ++n) y[bj][n] = y[bj][n] * rstd * g[bj][n];
                    if (fq == 0) {
#pragma unroll
                        for (int n = 0; n < 2; ++n) { const f32x4 c = *(const GAS f32x4*)(ct + pos * 8 + 4 * n), s = *(const GAS f32x4*)(st + pos * 8 + 4 * n);
                            const f32x4 x1 = y[0][n], x2 = y[1][n]; y[0][n] = x1 * c - x2 * s; y[1][n] = x2 * c + x1 * s; } }
                    if (isK) {
#pragma unroll
                        for (int bj = 0; bj < 2; ++bj)
#pragma unroll
                            for (int n = 0; n < 2; ++n) ks[bj][n] += y[bj][n];
                    } else {
#pragma unroll
                        for (int bj = 0; bj < 2; ++bj)
#pragma unroll
                            for (int n = 0; n < 2; ++n) y[bj][n] = y[bj][n] * C2A;
                    }
                    gbf rowp = base + (size_t)row * AW + head * 64;
#pragma unroll
                    for (int bj = 0; bj < 2; ++bj) { v4u w; w.x = cvt_pk_bf16(y[bj][0][0], y[bj][0][1]); w.y = cvt_pk_bf16(y[bj][0][2], y[bj][0][3]); w.z = cvt_pk_bf16(y[bj][1][0], y[bj][1][1]); w.w = cvt_pk_bf16(y[bj][1][2], y[bj][1][3]);
                        *(GAS v4u*)(rowp + 8 * (2 * fq + bj)) = w; } }
            if (isK) {
#pragma unroll
                for (int bj = 0; bj < 2; ++bj)
#pragma unroll
                    for (int n = 0; n < 2; ++n)
#pragma unroll
                        for (int e = 0; e < 4; ++e) { float v = ks[bj][n][e]; v += xshfl(v, 1, lane); v += xshfl(v, 2, lane); v += xshfl(v, 4, lane); v += xshfl(v, 8, lane); ks[bj][n][e] = v; }
                if (fr == 0) { gf32 kp = (gf32)(ws + WS_KMP) + ((size_t)(u.pm * 2 + wr) * 8 + head) * 64;
#pragma unroll
                    for (int bj = 0; bj < 2; ++bj)
#pragma unroll
                        for (int n = 0; n < 2; ++n) *(GAS f32x4*)(kp + 8 * (2 * fq + bj) + 4 * n) = ks[bj][n]; }
            }
            return;
        }
        size_t boff; int ld, colt; bool sig = false;
        if (u.pn < 6) { boff = WS_VA; ld = AW; colt = (u.pn & 1) * 256; }
        else if (u.pn < 9) { boff = WS_LAT; ld = LATW; colt = (u.pn - 6) * 256; }
        else { boff = WS_GATES; ld = 2048; colt = (u.pn - 9) * 256; sig = true; }
        gbf base = (gbf)(ws + boff);
        const bool lat = (u.pn >= 6 && u.pn < 9);
        const int row0 = u.pm * BM + wr * 64 + fr, col0 = colt + wc * 32 + 8 * fq;
        if (sig) {
            GAS unsigned char* gb = (GAS unsigned char*)(ws + WS_GATES);
#pragma unroll
            for (int ai = 0; ai < 2; ++ai)
#pragma unroll
                for (int m = 0; m < 4; ++m) { const int row = row0 + ai * HALF + m * 16; unsigned q[4];
#pragma unroll
                    for (int bj = 0; bj < 2; ++bj)
#pragma unroll
                        for (int n = 0; n < 2; ++n) { const f32x4 v = acc[ai][bj][m][n]; unsigned w = 0u;
#pragma unroll
                            for (int e = 0; e < 4; ++e) w |= (unsigned)__builtin_amdgcn_rcpf(__builtin_amdgcn_exp2f(v[e] - 7.99999436f) + (1.f / 255.999f)) << (8 * e);
                            q[2 * bj + n] = w; }
                    *(GAS v4u*)(gb + (size_t)row * 2048 + colt + wc * 64 + fq * 16) = (v4u){q[0], q[1], q[2], q[3]}; }
            return;
        }
#pragma unroll
        for (int ai = 0; ai < 2; ++ai)
#pragma unroll
            for (int m = 0; m < 4; ++m) { const int row = row0 + ai * HALF + m * 16; gbf rowp = base + (size_t)row * ld + col0;
#pragma unroll
                for (int bj = 0; bj < 2; ++bj) { f32x4 v0 = acc[ai][bj][m][0], v1 = acc[ai][bj][m][1];
                    if (lat) { float ss = (v0[0] * v0[0] + v0[1] * v0[1]) + (v0[2] * v0[2] + v0[3] * v0[3]) + (v1[0] * v1[0] + v1[1] * v1[1]) + (v1[2] * v1[2] + v1[3] * v1[3]);
                        ss += xshfl(ss, 16, lane); ss += xshfl(ss, 32, lane);
                        if (fq == 0) ((gf32)(ws + WS_SSLAT))[(size_t)row * 24 + (u.pn - 6) * 8 + bj * 4 + wc] = ss; }
                    v4u w; w.x = cvt_pk_bf16(v0[0], v0[1]); w.y = cvt_pk_bf16(v0[2], v0[3]); w.z = cvt_pk_bf16(v1[0], v1[1]); w.w = cvt_pk_bf16(v1[2], v1[3]);
                    *(GAS v4u*)(rowp + bj * HALF) = w; } }
    }
};
struct EpiUq {
    static constexpr bool PERM = true; static __device__ __forceinline__ bool chained(const Unit&) { return false; }
    gws_t ws;
    __device__ __forceinline__ void stash(const Unit& u, int tid, PG8_LAS unsigned* st) const {
        if (tid < BM) { gcf32 sp = (gcf32)(ws + WS_SSLAT) + (size_t)(u.pm * BM + tid) * 24;
            const f32x4 a = *(const GAS f32x4*)sp, b = *(const GAS f32x4*)(sp + 4), c = *(const GAS f32x4*)(sp + 8);
            const float ss = ((a[0] + a[1]) + (a[2] + a[3])) + ((b[0] + b[1]) + (b[2] + b[3])) + ((c[0] + c[1]) + (c[2] + c[3]));
            st[tid] = __float_as_uint(1.0f / sqrtf(ss * (1.f / QRANK) + EPS)); }
    }
    __device__ __forceinline__ void operator()(Acc& acc, const Unit& u, int wr, int wc, const PG8_LAS unsigned* st) const {
        const int ln_ = fresh_lane(), fr = ln_ & 15, fq = ln_ >> 4;
        gbf O = (gbf)(ws + WS_QB);
        const int r0 = wr * 64 + fr, col0 = u.pn * BM + wc * 32 + 8 * fq;
#pragma unroll
        for (int ai = 0; ai < 2; ++ai)
#pragma unroll
            for (int m = 0; m < 4; ++m) { const int r = r0 + ai * HALF + m * 16; const float rstd = __uint_as_float(st[r]);
                gbf rowp = O + (size_t)(u.pm * BM + r) * 768 + col0;
#pragma unroll
                for (int bj = 0; bj < 2; ++bj) { const f32x4 v0 = acc[ai][bj][m][0] * rstd, v1 = acc[ai][bj][m][1] * rstd;
                    v4u w; w.x = cvt_pk_bf16(v0[0], v0[1]); w.y = cvt_pk_bf16(v0[2], v0[3]); w.z = cvt_pk_bf16(v1[0], v1[1]); w.w = cvt_pk_bf16(v1[2], v1[3]);
                    *(GAS v4u*)(rowp + bj * HALF) = w; } }
    }
};
struct EpiUkvK {
    static constexpr bool PERM = true; static __device__ __forceinline__ bool chained(const Unit&) { return false; }
    gws_t ws; gcf32 gk;
    __device__ __forceinline__ void stash(const Unit& u, int tid, PG8_LAS unsigned* st) const {
        if (tid < BM) { gcf32 sp = (gcf32)(ws + WS_SSLAT) + (size_t)(u.pm * BM + tid) * 24;
            const f32x4 a = *(const GAS f32x4*)(sp + 12), b = *(const GAS f32x4*)(sp + 16);
            st[2 * tid] = __float_as_uint(1.0f / sqrtf((((a[0] + a[1]) + (a[2] + a[3])) + ((b[0] + b[1]) + (b[2] + b[3]))) * (1.f / KVRANK) + EPS)); st[2 * tid + 1] = __float_as_uint(sp[20]); }
    }
    __device__ __forceinline__ void operator()(Acc& acc, const Unit& u, int wr, int wc, const PG8_LAS unsigned* st) const {
        const int ln_ = fresh_lane(), fr = ln_ & 15, fq = ln_ >> 4;
        const int lane = fq * 16 + fr; gcf32 SS = (gcf32)(ws + WS_SSLAT);
        const int row0 = u.pm * BM + wr * 64 + fr;
        {
            const int head = 4 * u.pn + wc; gbf KBp = (gbf)(ws + WS_KB);
            float rhs[8];
            {
                f32x4 g[2][2];
#pragma unroll
                for (int bj = 0; bj < 2; ++bj)
#pragma unroll
                    for (int n = 0; n < 2; ++n) g[bj][n] = *(const GAS f32x4*)(gk + 32 * bj + 8 * fq + 4 * n);
#pragma unroll
                for (int ai = 0; ai < 2; ++ai)
#pragma unroll
                    for (int m = 0; m < 4; ++m) { const int row = row0 + ai * HALF + m * 16; const int rl = wr * 64 + fr + ai * HALF + m * 16;
                        const float rc = __uint_as_float(st[2 * rl]), sskr = __uint_as_float(st[2 * rl + 1]);
                        f32x4 y[2][2]; float ss = 0.f;
#pragma unroll
                        for (int bj = 0; bj < 2; ++bj)
#pragma unroll
                            for (int n = 0; n < 2; ++n) { y[bj][n] = acc[ai][bj][m][n] * rc; ss += (y[bj][n][0] * y[bj][n][0] + y[bj][n][1] * y[bj][n][1]) + (y[bj][n][2] * y[bj][n][2] + y[bj][n][3] * y[bj][n][3]); }
                        ss += xshfl(ss, 16, lane); ss += xshfl(ss, 32, lane);
                        const float rh = 1.0f / sqrtf((ss + sskr) * (1.f / 96.f) + EPS);
                        rhs[ai * 4 + m] = rh;
                        gbf rowp = KBp + (size_t)row * 768 + head * 96;
#pragma unroll
                        for (int bj = 0; bj < 2; ++bj) { const f32x4 v0 = y[bj][0] * rh * g[bj][0], v1 = y[bj][1] * rh * g[bj][1];
                            v4u w; w.x = cvt_pk_bf16(v0[0], v0[1]); w.y = cvt_pk_bf16(v0[2], v0[3]); w.z = cvt_pk_bf16(v1[0], v1[1]); w.w = cvt_pk_bf16(v1[2], v1[3]);
                            *(GAS v4u*)(rowp + 32 * bj + 8 * fq) = w; }
                        asm volatile("" ::: "memory"); }
            }
            {
                gcbf LATp = (gcbf)(ws + WS_LAT); gcf32 ct = (gcf32)(ws + WS_ROPE) + 2 * 4096 * 8, st = ct + 4096 * 16;
                const int ro = 8 * fq, rp = (8 * fq + 16) & 31, ci = (8 * fq) & 15;
                const f32x4 go0 = *(const GAS f32x4*)(gk + 64 + ro), go1 = *(const GAS f32x4*)(gk + 64 + ro + 4), gp0 = *(const GAS f32x4*)(gk + 64 + rp), gp1 = *(const GAS f32x4*)(gk + 64 + rp + 4);
#pragma unroll
                for (int ai = 0; ai < 2; ++ai)
#pragma unroll
                    for (int m = 0; m < 4; ++m) { const int row = row0 + ai * HALF + m * 16, pos = row & (SEQ - 1); const float rh = rhs[ai * 4 + m];
                        const v4u wo = *(const GAS v4u*)(LATp + (size_t)row * LATW + 640 + ro), wp = *(const GAS v4u*)(LATp + (size_t)row * LATW + 640 + rp);
                        const f32x4 c0 = *(const GAS f32x4*)(ct + pos * 16 + ci), c1 = *(const GAS f32x4*)(ct + pos * 16 + ci + 4), s0 = *(const GAS f32x4*)(st + pos * 16 + ci), s1 = *(const GAS f32x4*)(st + pos * 16 + ci + 4);
                        const f32x4 xo0 = (f32x4){bf_lo(wo.x), bf_hi(wo.x), bf_lo(wo.y), bf_hi(wo.y)} * go0 * rh, xo1 = (f32x4){bf_lo(wo.z), bf_hi(wo.z), bf_lo(wo.w), bf_hi(wo.w)} * go1 * rh;
                        const f32x4 xp0 = (f32x4){bf_lo(wp.x), bf_hi(wp.x), bf_lo(wp.y), bf_hi(wp.y)} * gp0 * rh, xp1 = (f32x4){bf_lo(wp.z), bf_hi(wp.z), bf_lo(wp.w), bf_hi(wp.w)} * gp1 * rh;
                        f32x4 o0, o1;
                        if (fq < 2) { o0 = xo0 * c0 - xp0 * s0; o1 = xo1 * c1 - xp1 * s1; } else { o0 = xo0 * c0 + xp0 * s0; o1 = xo1 * c1 + xp1 * s1; }
                        v4u w; w.x = cvt_pk_bf16(o0[0], o0[1]); w.y = cvt_pk_bf16(o0[2], o0[3]); w.z = cvt_pk_bf16(o1[0], o1[1]); w.w = cvt_pk_bf16(o1[2], o1[3]);
                        *(GAS v4u*)(KBp + (size_t)row * 768 + head * 96 + 64 + ro) = w;
                        asm volatile("" ::: "memory"); }
            }
        }
    }
};
struct EpiUkvV {
    static constexpr bool PERM = true; static __device__ __forceinline__ bool chained(const Unit&) { return false; }
    gws_t ws;
    __device__ __forceinline__ void stash(const Unit& u, int tid, PG8_LAS unsigned* st) const {
        if (tid < BM) { gcf32 sp = (gcf32)(ws + WS_SSLAT) + (size_t)(u.pm * BM + tid) * 24;
            const f32x4 a = *(const GAS f32x4*)(sp + 12), b = *(const GAS f32x4*)(sp + 16);
            st[tid] = __float_as_uint(1.0f / sqrtf((((a[0] + a[1]) + (a[2] + a[3])) + ((b[0] + b[1]) + (b[2] + b[3]))) * (1.f / KVRANK) + EPS)); }
    }
    __device__ __forceinline__ void operator()(Acc& acc, const Unit& u, int wr, int wc, const PG8_LAS unsigned* st) const {
        const int ln_ = fresh_lane(), fr = ln_ & 15, fq = ln_ >> 4;
        const int r0 = wr * 64 + fr;
        gbf Vp = (gbf)(ws + WS_KVR); const int col0 = u.pn * BM + wc * 32 + 8 * fq;
#pragma unroll
        for (int ai = 0; ai < 2; ++ai)
#pragma unroll
            for (int m = 0; m < 4; ++m) { const int r = r0 + ai * HALF + m * 16; const float rc = __uint_as_float(st[r]);
                gbf rowp = Vp + (size_t)(u.pm * BM + r) * 512 + col0;
#pragma unroll
                for (int bj = 0; bj < 2; ++bj) { const f32x4 v0 = acc[ai][bj][m][0] * rc, v1 = acc[ai][bj][m][1] * rc;
                    v4u w; w.x = cvt_pk_bf16(v0[0], v0[1]); w.y = cvt_pk_bf16(v0[2], v0[3]); w.z = cvt_pk_bf16(v1[0], v1[1]); w.w = cvt_pk_bf16(v1[2], v1[3]);
                    *(GAS v4u*)(rowp + bj * HALF) = w; } }
    }
};
struct EpiPlain {
    static constexpr bool PERM = true; static __device__ __forceinline__ bool chained(const Unit&) { return false; } __device__ __forceinline__ void stash(const Unit&, int, PG8_LAS unsigned*) const {}
    gbf O; int ldc;
    __device__ __forceinline__ void operator()(Acc& acc, const Unit& u, int wr, int wc, const PG8_LAS unsigned* st) const {
        const int ln_ = fresh_lane(), fr = ln_ & 15, fq = ln_ >> 4;
        const int row0 = u.pm * BM + wr * 64 + fr, col0 = u.pn * BM + wc * 32 + 8 * fq;
#pragma unroll
        for (int ai = 0; ai < 2; ++ai)
#pragma unroll
            for (int m = 0; m < 4; ++m) { gbf rowp = O + (size_t)(row0 + ai * HALF + m * 16) * ldc + col0;
#pragma unroll
                for (int bj = 0; bj < 2; ++bj) { const f32x4 v0 = acc[ai][bj][m][0], v1 = acc[ai][bj][m][1];
                    v4u w; w.x = cvt_pk_bf16(v0[0], v0[1]); w.y = cvt_pk_bf16(v0[2], v0[3]); w.z = cvt_pk_bf16(v1[0], v1[1]); w.w = cvt_pk_bf16(v1[2], v1[3]);
                    *(GAS v4u*)(rowp + bj * HALF) = w; } }
    }
};
struct EpiBranch {
    static constexpr bool PERM = true; static __device__ __forceinline__ bool chained(const Unit& u) { return u.e == 0; } __device__ __forceinline__ void stash(const Unit&, int, PG8_LAS unsigned*) const {}
    gbf O; const GAS unsigned char* G;
    static __device__ __forceinline__ float dq(unsigned w, int k) { return ((float)((w >> (8 * k)) & 255u) + 0.5f) * (1.f / 256.f); }
    __device__ __forceinline__ void operator()(Acc& acc, const Unit& u, int wr, int wc, const PG8_LAS unsigned* st) const {
        const int ln_ = fresh_lane(), fr = ln_ & 15, fq = ln_ >> 4;
        const int row0 = u.pm * BM + wr * 64 + fr, col0 = u.pn * BM + wc * 32 + 8 * fq, gcol = u.pn * BM + wc * 64 + fq * 16;
#pragma unroll
        for (int ai = 0; ai < 2; ++ai) { v4u gbv[4], gav[4];
#pragma unroll
            for (int m = 0; m < 4; ++m) { const size_t r = (size_t)(row0 + ai * HALF + m * 16);
                gbv[m] = *(const GAS v4u*)(G + r * 2048 + 1024 + gcol);
                if (u.e == 0) gav[m] = *(const GAS v4u*)(G + r * 2048 + gcol); }
#pragma unroll
            for (int m = 0; m < 4; ++m) { const size_t r = (size_t)(row0 + ai * HALF + m * 16);
#pragma unroll
                for (int bj = 0; bj < 2; ++bj) { f32x4& v0 = acc[ai][bj][m][0]; f32x4& v1 = acc[ai][bj][m][1];
                    const unsigned b0 = gbv[m][2 * bj], b1 = gbv[m][2 * bj + 1];
                    const float sb[8] = { dq(b0, 0), dq(b0, 1), dq(b0, 2), dq(b0, 3), dq(b1, 0), dq(b1, 1), dq(b1, 2), dq(b1, 3) };
                    if (u.e == 0) {
                        const unsigned a0 = gav[m][2 * bj], a1 = gav[m][2 * bj + 1];
                        const float sa[8] = { dq(a0, 0), dq(a0, 1), dq(a0, 2), dq(a0, 3), dq(a1, 0), dq(a1, 1), dq(a1, 2), dq(a1, 3) };
#pragma unroll
                        for (int q = 0; q < 4; ++q) { v0[q] *= sa[q] * __builtin_amdgcn_rcpf(sb[q]); v1[q] *= sa[4 + q] * __builtin_amdgcn_rcpf(sb[4 + q]); }
                    } else {
                        v4u w; w.x = cvt_pk_bf16(v0[0] * sb[0], v0[1] * sb[1]); w.y = cvt_pk_bf16(v0[2] * sb[2], v0[3] * sb[3]); w.z = cvt_pk_bf16(v1[0] * sb[4], v1[1] * sb[5]); w.w = cvt_pk_bf16(v1[2] * sb[6], v1[3] * sb[7]);
                        *(GAS v4u*)(O + r * D + col0 + bj * HALF) = w; } } } }
    }
};
template <bool F32IN> struct EpiResidB {
    static constexpr bool PERM = true; static __device__ __forceinline__ bool chained(const Unit&) { return false; } __device__ __forceinline__ void stash(const Unit&, int, PG8_LAS unsigned*) const {}
    const GAS void* base; gbf out;
    __device__ __forceinline__ void operator()(Acc& acc, const Unit& u, int wr, int wc, const PG8_LAS unsigned* st) const {
        const int ln_ = fresh_lane(), fr = ln_ & 15, fq = ln_ >> 4;
        const int row0 = u.pm * BM + wr * 64 + fr, col0 = u.pn * BM + wc * 32 + 8 * fq;
#pragma unroll
        for (int ai = 0; ai < 2; ++ai)
#pragma unroll
            for (int mp = 0; mp < 2; ++mp) { f32x4 b[2][2][2];
#pragma unroll
                for (int mm = 0; mm < 2; ++mm) { const size_t off = (size_t)(row0 + ai * HALF + (2 * mp + mm) * 16) * D + col0;
#pragma unroll
                    for (int bj = 0; bj < 2; ++bj) {
                        if (F32IN) { b[mm][bj][0] = *(const GAS f32x4*)((gcf32)base + off + bj * HALF); b[mm][bj][1] = *(const GAS f32x4*)((gcf32)base + off + bj * HALF + 4); }
                        else { const v4u w = *(const GAS v4u*)((gcbf)base + off + bj * HALF);
                            b[mm][bj][0] = (f32x4){bf_lo(w.x), bf_hi(w.x), bf_lo(w.y), bf_hi(w.y)}; b[mm][bj][1] = (f32x4){bf_lo(w.z), bf_hi(w.z), bf_lo(w.w), bf_hi(w.w)}; } } }
#pragma unroll
                for (int mm = 0; mm < 2; ++mm) { const size_t off = (size_t)(row0 + ai * HALF + (2 * mp + mm) * 16) * D + col0;
#pragma unroll
                    for (int bj = 0; bj < 2; ++bj) { const f32x4 v0 = b[mm][bj][0] + acc[ai][bj][2 * mp + mm][0], v1 = b[mm][bj][1] + acc[ai][bj][2 * mp + mm][1];
                        v4u w; w.x = cvt_pk_bf16(v0[0], v0[1]); w.y = cvt_pk_bf16(v0[2], v0[3]); w.z = cvt_pk_bf16(v1[0], v1[1]); w.w = cvt_pk_bf16(v1[2], v1[3]);
                        *(GAS v4u*)(out + off + bj * HALF) = w; } } }
    }
};
struct EpiSwiGLU {
    static constexpr bool PERM = true; static __device__ __forceinline__ bool chained(const Unit&) { return false; } __device__ __forceinline__ void stash(const Unit&, int, PG8_LAS unsigned*) const {}
    gbf O;
    __device__ __forceinline__ void operator()(Acc& acc, const Unit& u, int wr, int wc, const PG8_LAS unsigned* st) const {
        const int ln_ = fresh_lane(), fr = ln_ & 15, fq = ln_ >> 4;
        const int row0 = u.pm * BM + wr * 64 + fr, col0 = u.pn * 128 + wc * 32 + 8 * fq;
#pragma unroll
        for (int ai = 0; ai < 2; ++ai)
#pragma unroll
            for (int m = 0; m < 4; ++m) { gbf rowp = O + (size_t)(row0 + ai * HALF + m * 16) * DFF + col0; float o[8];
#pragma unroll
                for (int n = 0; n < 2; ++n) { const f32x4 g = acc[ai][0][m][n], up = acc[ai][1][m][n];
#pragma unroll
                    for (int e = 0; e < 4; ++e) o[4 * n + e] = g[e] * up[e] * __builtin_amdgcn_rcpf(1.0f + __builtin_amdgcn_exp2f(g[e])); }
                v4u w; w.x = cvt_pk_bf16(o[0], o[1]); w.y = cvt_pk_bf16(o[2], o[3]); w.z = cvt_pk_bf16(o[4], o[5]); w.w = cvt_pk_bf16(o[6], o[7]);
                *(GAS v4u*)rowp = w; }
    }
};
struct EpiMoeDown {
    static constexpr bool PERM = true; static __device__ __forceinline__ bool chained(const Unit&) { return false; }
    gbf Y; const volatile PG8_LAS int* tab; const GAS int* list; gcf32 tokp;
    __device__ __forceinline__ void stash(const Unit& u, int tid, PG8_LAS unsigned* st) const {
        if (tid < BM) { const int pos = (u.pm - tab[u.e]) * BM + tid; unsigned dst = 0xffffffffu; float p = 0.f;
            if (pos < tab[16 + u.e]) { const int ent = list[u.e * 32768 + pos]; dst = (unsigned)((ent & 1) * M + (ent >> 1)); p = tokp[ent]; }
            st[2 * tid] = dst; st[2 * tid + 1] = __float_as_uint(p); }
    }
    __device__ __forceinline__ void operator()(Acc& acc, const Unit& u, int wr, int wc, const PG8_LAS unsigned* st) const {
        const int ln_ = fresh_lane(), fr = ln_ & 15, fq = ln_ >> 4;
        const int col0 = u.pn * BM + wc * 32 + 8 * fq;
        const int r0 = wr * 64 + fr;
#pragma unroll
        for (int ai = 0; ai < 2; ++ai)
#pragma unroll
            for (int m = 0; m < 4; ++m) { const int r = r0 + ai * HALF + m * 16; const unsigned dst = st[2 * r]; const float p = __uint_as_float(st[2 * r + 1]);
                if (dst != 0xffffffffu) {
                    gbf rowp = Y + (size_t)dst * D + col0;
#pragma unroll
                    for (int bj = 0; bj < 2; ++bj) { const f32x4 v0 = acc[ai][bj][m][0] * p, v1 = acc[ai][bj][m][1] * p;
                        v4u w; w.x = cvt_pk_bf16(v0[0], v0[1]); w.y = cvt_pk_bf16(v0[2], v0[3]); w.z = cvt_pk_bf16(v1[0], v1[1]); w.w = cvt_pk_bf16(v1[2], v1[3]);
                        *(GAS v4u*)(rowp + bj * HALF) = w; } } }
    }
};
}

namespace att {
typedef LAS const char* lds_cptr;
__device__ __forceinline__ int crow(int r, int hi) { return (r & 3) + 8 * (r >> 2) + 4 * hi; }
__device__ __forceinline__ void glds16(const GAS void* gsrc, unsigned lds_dst) { unsigned keep;
    asm volatile("s_mov_b32 %0, m0\n\ts_mov_b32 m0, %2\n\ts_nop 0\n\tglobal_load_lds_dwordx4 %1, off\n\ts_mov_b32 m0, %0" : "=&s"(keep) : "v"(gsrc), "s"(lds_dst) : "memory"); }
#define ATT_WAIT_BAR() asm volatile("s_waitcnt vmcnt(0) lgkmcnt(0)\n\ts_barrier" ::: "memory")
__device__ __forceinline__ float swap_half(float v, int hi) { auto rr = __builtin_amdgcn_permlane32_swap(__float_as_uint(v), __float_as_uint(v), false, false); return __uint_as_float(hi ? rr[0] : rr[1]); }

typedef short v4i16_t __attribute__((ext_vector_type(4)));
__device__ __forceinline__ s16x4 vtr(lds_cptr p) { return __builtin_bit_cast(s16x4, __builtin_amdgcn_ds_read_tr16_b64_v4i16((LAS v4i16_t*)p)); }
__device__ __forceinline__ void pv(f32x16* o, int vb, bf16x8 pa0, bf16x8 pa1, bf16x8 pa2, bf16x8 pa3) {
#pragma unroll
    for (int d0 = 0; d0 < 2; ++d0) { s16x4 lo[4], hi[4];
#pragma unroll
        for (int ks = 0; ks < 4; ++ks) {
            asm volatile("ds_read_b64_tr_b16 %0,%1 offset:%c2" : "=&v"(lo[ks]) : "v"(vb), "i"(d0 * 4096 + ks * 1024) : "memory");
            asm volatile("ds_read_b64_tr_b16 %0,%1 offset:%c2" : "=&v"(hi[ks]) : "v"(vb), "i"(d0 * 4096 + ks * 1024 + 512) : "memory"); }
        asm volatile("s_waitcnt lgkmcnt(0)" ::: "memory"); __builtin_amdgcn_sched_barrier(0);
#define ATT_PK(k) (bf16x8){lo[k][0], lo[k][1], lo[k][2], lo[k][3], hi[k][0], hi[k][1], hi[k][2], hi[k][3]}
        o[d0] = __builtin_amdgcn_mfma_f32_32x32x16_bf16(pa0, ATT_PK(0), o[d0], 0, 0, 0);
        o[d0] = __builtin_amdgcn_mfma_f32_32x32x16_bf16(pa1, ATT_PK(1), o[d0], 0, 0, 0);
        o[d0] = __builtin_amdgcn_mfma_f32_32x32x16_bf16(pa2, ATT_PK(2), o[d0], 0, 0, 0);
        o[d0] = __builtin_amdgcn_mfma_f32_32x32x16_bf16(pa3, ATT_PK(3), o[d0], 0, 0, 0);
#undef ATT_PK
    }
}

template <int DQK, bool MOBA>
__device__ __forceinline__ void attn_unit(int wave0, int b, int h, int qb, gcbf Q, int ldq, gcbf K, int ldk, gcbf V, int ldv, gbf O, int ldo,
                                          LAS unsigned char* shm, gcf32 kmean_bh, gcf32 qgain, gcf32 ropeB) {
    constexpr int ND0 = DQK / 16, NCH = DQK / 8, KSLOT = NCH * 1024, NSL = 4;
    constexpr int LDS_K = 0, LDS_V = NSL * KSLOT, LDS_WS = LDS_V + NSL * 8192, LDS_OST = LDS_WS + 2048, LDS_KM = LDS_OST + 32768;
    static_assert(LDS_KM + 4096 <= RING_BYTES, "attention LDS");
    const int tid = phase_tid(wave0);
    const int lane = tid & 63, r32 = lane & 31, hi = lane >> 5; const int wid = __builtin_amdgcn_readfirstlane(tid >> 6);
    const long rowbase = (long)b * SEQ; const int q0 = qb * 256;
    gcbf Qw = Q + (rowbase + q0 + wid * 32) * ldq + h * DQK;
    gcbf Kh = K + rowbase * ldk + h * DQK; gcbf Vh = V + rowbase * ldv + h * 64;
    const unsigned lds0 = (unsigned)(uintptr_t)shm;
    LAS float* wsf = (LAS float*)(shm + LDS_WS) + wid * 64;
    LAS float* kml = (LAS float*)(shm + LDS_KM);
    const int NT = 4 * (qb + 1);
#define ATT_DMA(t, s) do { \
        for (int c_ = wid; c_ < NCH; c_ += 8) glds16(Kh + (long)((t) * 64 + lane) * ldk + c_ * 8, (unsigned)__builtin_amdgcn_readfirstlane(lds0 + LDS_K + (s) * KSLOT + c_ * 1024)); \
        glds16(Vh + (long)((t) * 64 + 16 * (wid & 3) + (lane >> 2)) * ldv + (wid >> 2) * 32 + (lane & 3) * 8, (unsigned)__builtin_amdgcn_readfirstlane(lds0 + LDS_V + (s) * 8192 + wid * 1024)); } while (0)
    if (MOBA) { for (int i = tid; i < qb * 64; i += 512) { const int n = i >> 6, d = i & 63; kml[i] = (kmean_bh[(size_t)n * 1024 + d] + kmean_bh[(size_t)n * 1024 + 512 + d]) * (1.f / 256.f); } }
    bf16x8 qr[ND0];
#pragma unroll
    for (int d0 = 0; d0 < ND0; ++d0) qr[d0] = *(const GAS bf16x8*)(Qw + (long)r32 * ldq + d0 * 16 + hi * 8);
    if constexpr (!MOBA) {
        float qf[ND0][8]; float ss = 0.f;
#pragma unroll
        for (int d0 = 0; d0 < ND0; ++d0)
#pragma unroll
            for (int j = 0; j < 8; ++j) { qf[d0][j] = __uint_as_float(((unsigned)(unsigned short)qr[d0][j]) << 16); ss += qf[d0][j] * qf[d0][j]; }
        ss += swap_half(ss, hi);
        const float rstd = 1.0f / sqrtf(ss * (1.f / 96.f) + EPS) * C2B;
#pragma unroll
        for (int d0 = 0; d0 < ND0; ++d0)
#pragma unroll
            for (int j = 0; j < 8; ++j) qf[d0][j] *= rstd * qgain[d0 * 16 + hi * 8 + j];
        const int pos = q0 + wid * 32 + r32;
#pragma unroll
        for (int j = 0; j < 8; ++j) { const float c = ropeB[pos * 16 + 8 * hi + j], s = ropeB[4096 * 16 + pos * 16 + 8 * hi + j]; const float x1 = qf[4][j], x2 = qf[5][j]; qf[4][j] = x1 * c - x2 * s; qf[5][j] = x2 * c + x1 * s; }
#pragma unroll
        for (int d0 = 0; d0 < ND0; ++d0) { v4u w; w.x = cvt_pk_bf16(qf[d0][0], qf[d0][1]); w.y = cvt_pk_bf16(qf[d0][2], qf[d0][3]); w.z = cvt_pk_bf16(qf[d0][4], qf[d0][5]); w.w = cvt_pk_bf16(qf[d0][6], qf[d0][7]); qr[d0] = __builtin_bit_cast(bf16x8, w); }
    }
    ATT_DMA(0, 0); ATT_DMA(1, 1); ATT_DMA(2, 2);
    unsigned selmask = 0xffffffffu;
    if (MOBA) {
        __syncthreads();
        if (qb <= 3) selmask = (1u << qb) - 1u;
        else {
            float b1 = -INFINITY, b2 = -INFINITY, b3 = -INFINITY; int i1 = 0, i2 = 0, i3 = 0;
            for (int n = 0; n < qb; ++n) {
                float g = 0.f;
#pragma unroll
                for (int d0 = 0; d0 < ND0; ++d0)
#pragma unroll
                    for (int j = 0; j < 8; ++j) g += __uint_as_float(((unsigned)(unsigned short)qr[d0][j]) << 16) * kml[n * 64 + d0 * 16 + hi * 8 + j];
                g += swap_half(g, hi);
                if (g > b1) { b3 = b2; i3 = i2; b2 = b1; i2 = i1; b1 = g; i1 = n; }
                else if (g > b2) { b3 = b2; i3 = i2; b2 = g; i2 = n; }
                else if (g > b3) { b3 = g; i3 = n; }
            }
            selmask = (1u << i1) | (1u << i2) | (1u << i3);
        }
    }
    float m_ref = 0.f, l_reg = 0.f; f32x16 o[2]; o[0] = f32x16{}; o[1] = f32x16{};
    f32x16 negm = f32x16{};
    const int qrel = wid * 32 + r32;
    const lds_cptr vp0 = (lds_cptr)shm + LDS_V + ((lane >> 4) & 1) * 32 + (lane & 3) * 8 + (4 * hi + ((lane & 15) >> 2)) * 64;
#define ATT_TILE(t, FIRST, DIAG) do { \
        if (wid < NCH - 8) asm volatile("s_waitcnt vmcnt(6) lgkmcnt(0)\n\ts_barrier" ::: "memory"); \
        else asm volatile("s_waitcnt vmcnt(4) lgkmcnt(0)\n\ts_barrier" ::: "memory"); \
        { const int tn = ((t) + 3 < NT) ? (t) + 3 : NT - 1; ATT_DMA(tn, ((t) + 3) & 3); } \
        const int slot = (t) & 3; \
        f32x16 p0, p1; \
          \
        bf16x8 kf[2 * ND0]; s16x4 vlo[8], vhi[8]; \
        { lds_cptr kb = (lds_cptr)shm + LDS_K + slot * KSLOT + hi * 1024 + r32 * 16; \
          _Pragma("unroll") for (int d0 = 0; d0 < ND0; ++d0) { kf[2 * d0] = *(const LAS bf16x8*)(kb + d0 * 2048); kf[2 * d0 + 1] = *(const LAS bf16x8*)(kb + d0 * 2048 + 512); } \
          lds_cptr vp_ = vp0 + slot * 8192; \
          _Pragma("unroll") for (int i = 0; i < 8; ++i) { vlo[i] = vtr(vp_ + ((i >> 2) * 4096 + (i & 3) * 1024)); vhi[i] = vtr(vp_ + ((i >> 2) * 4096 + (i & 3) * 1024 + 512)); } \
          __builtin_amdgcn_sched_barrier(0); \
          _Pragma("unroll") for (int d0 = 0; d0 < ND0; ++d0) { \
              if (d0 == 0) { p0 = __builtin_amdgcn_mfma_f32_32x32x16_bf16(kf[0], qr[0], negm, 0, 0, 0); p1 = __builtin_amdgcn_mfma_f32_32x32x16_bf16(kf[1], qr[0], negm, 0, 0, 0); } \
              else { p0 = __builtin_amdgcn_mfma_f32_32x32x16_bf16(kf[2 * d0], qr[d0], p0, 0, 0, 0); p1 = __builtin_amdgcn_mfma_f32_32x32x16_bf16(kf[2 * d0 + 1], qr[d0], p1, 0, 0, 0); } } } \
        if (DIAG) { const int kb_ = 64 * ((t) & 3) + 4 * hi; \
            _Pragma("unroll") for (int r = 0; r < 16; ++r) { const int kv = kb_ + (r & 3) + 8 * (r >> 2); if (kv > qrel) p0[r] = -INFINITY; if (kv + 32 > qrel) p1[r] = -INFINITY; } } \
        float ra = fmaxf(fmaxf(p0[0], p0[1]), p1[0]), rb = fmaxf(fmaxf(p0[2], p0[3]), p1[1]); ra = fmaxf(fmaxf(ra, p1[2]), p1[3]); \
        _Pragma("unroll") for (int r = 4; r < 16; r += 4) { ra = fmaxf(fmaxf(ra, p0[r]), p0[r + 1]); rb = fmaxf(fmaxf(rb, p0[r + 2]), p0[r + 3]); ra = fmaxf(fmaxf(ra, p1[r]), p1[r + 1]); rb = fmaxf(fmaxf(rb, p1[r + 2]), p1[r + 3]); } \
        float rm = fmaxf(ra, rb); rm = fmaxf(rm, swap_half(rm, hi)); \
        if (FIRST) { m_ref = fmaxf(rm, -1e30f); \
            _Pragma("unroll") for (int r = 0; r < 16; ++r) { p0[r] -= m_ref; p1[r] -= m_ref; negm[r] = -m_ref; } \
        } else if (__any(rm > 8.0f)) {                         \
            const float dl = fmaxf(rm, 0.f), alpha = __builtin_amdgcn_exp2f(-dl); \
            m_ref += dl; l_reg *= alpha; \
            _Pragma("unroll") for (int r = 0; r < 16; ++r) { p0[r] -= dl; p1[r] -= dl; negm[r] = -m_ref; } \
            if (hi == 0) wsf[r32] = alpha; \
            LDS_WAIT(); \
            _Pragma("unroll") for (int r = 0; r < 16; ++r) { const float a = wsf[crow(r, hi)]; o[0][r] *= a; o[1][r] *= a; } } \
        float sacc = 0.f; \
        _Pragma("unroll") for (int r = 0; r < 16; ++r) { p0[r] = __builtin_amdgcn_exp2f(p0[r]); p1[r] = __builtin_amdgcn_exp2f(p1[r]); sacc += p0[r] + p1[r]; } \
        l_reg += sacc; \
        v4u pw0, pw1, pw2, pw3; \
        pw0 = (v4u){cvt_pk_bf16(p0[0], p0[1]), cvt_pk_bf16(p0[2], p0[3]), cvt_pk_bf16(p0[4], p0[5]), cvt_pk_bf16(p0[6], p0[7])}; \
        pw1 = (v4u){cvt_pk_bf16(p0[8], p0[9]), cvt_pk_bf16(p0[10], p0[11]), cvt_pk_bf16(p0[12], p0[13]), cvt_pk_bf16(p0[14], p0[15])}; \
        pw2 = (v4u){cvt_pk_bf16(p1[0], p1[1]), cvt_pk_bf16(p1[2], p1[3]), cvt_pk_bf16(p1[4], p1[5]), cvt_pk_bf16(p1[6], p1[7])}; \
        pw3 = (v4u){cvt_pk_bf16(p1[8], p1[9]), cvt_pk_bf16(p1[10], p1[11]), cvt_pk_bf16(p1[12], p1[13]), cvt_pk_bf16(p1[14], p1[15])}; \
        { const bf16x8 pa[4] = { __builtin_bit_cast(bf16x8, pw0), __builtin_bit_cast(bf16x8, pw1), __builtin_bit_cast(bf16x8, pw2), __builtin_bit_cast(bf16x8, pw3) }; \
          _Pragma("unroll") for (int i = 0; i < 8; ++i) { const bf16x8 vf = (bf16x8){vlo[i][0], vlo[i][1], vlo[i][2], vlo[i][3], vhi[i][0], vhi[i][1], vhi[i][2], vhi[i][3]}; \
              o[i >> 2] = __builtin_amdgcn_mfma_f32_32x32x16_bf16(pa[i & 3], vf, o[i >> 2], 0, 0, 0); } } \
    } while (0)
    static_assert(!MOBA, "this body serves the MLA mixer; MoBA runs att64::attn_unit");
    if (NT == 4) { ATT_TILE(0, true, true); for (int t = 1; t < 4; ++t) ATT_TILE(t, false, true); }
    else { ATT_TILE(0, true, false); for (int t = 1; t < NT - 4; ++t) ATT_TILE(t, false, false); for (int t = NT - 4; t < NT; ++t) ATT_TILE(t, false, true); }
#undef ATT_TILE
    l_reg += swap_half(l_reg, hi);
    if (hi == 0) wsf[32 + r32] = l_reg;
    LDS_WAIT();
    float rli[16];
#pragma unroll
    for (int r = 0; r < 16; ++r) rli[r] = __builtin_amdgcn_rcpf(wsf[32 + crow(r, hi)]);
    gbf Ow = O + (rowbase + q0 + wid * 32) * ldo + h * 64;
    { LAS bf16* stg = (LAS bf16*)(shm + LDS_OST) + wid * 2048;
#pragma unroll
      for (int r = 0; r < 16; ++r) { const int orow = crow(r, hi);
#pragma unroll
          for (int d0 = 0; d0 < 2; ++d0) stg[orow * 64 + d0 * 32 + r32] = (bf16)(cvt_pk_bf16(o[d0][r] * rli[r], 0.f) & 0xffffu); }
      LDS_WAIT();
#pragma unroll
      for (int i = 0; i < 4; ++i) { const int row = i * 8 + (lane >> 3), ch = lane & 7; const v4u v = *(const LAS v4u*)(stg + row * 64 + ch * 8); *(GAS v4u*)(Ow + (long)row * ldo + ch * 8) = v; } }
    asm volatile("s_waitcnt vmcnt(0) lgkmcnt(0)\n\ts_barrier" ::: "memory");
#undef ATT_DMA
}
}

namespace att64 {
using bf16x8=__attribute__((ext_vector_type(8)))short;
using s16x4=__attribute__((ext_vector_type(4)))short;
using f32x16=__attribute__((ext_vector_type(16)))float;
using u32x4=__attribute__((ext_vector_type(4)))unsigned;
constexpr int SEQ=4096,D=64,DM=512;
constexpr int NW=8,QBLK=32,QB=QBLK*NW,KVBLK=64;
typedef LAS const char* lds_cptr;
typedef short v4i16_t __attribute__((ext_vector_type(4)));
__device__ __forceinline__ int crow(int r,int hi){return (r&3)+8*(r>>2)+4*hi;}
#define SBAR() __builtin_amdgcn_sched_barrier(0)
__device__ __forceinline__ void cmask(f32x16&p0,f32x16&p1,int jb,int qrel,int hi){
  const float NEG=-INFINITY; int kb=64*jb+4*hi;
  #pragma unroll
  for(int r=0;r<16;++r){int kv=kb+(r&3)+8*(r>>2); if(kv>qrel)p0[r]=NEG; if(kv+32>qrel)p1[r]=NEG;}
}

constexpr int NSLOT=3;
constexpr float NEGB=-30000.f;
__device__ __forceinline__ void glds16(const GAS void*gsrc,unsigned lds_dst){unsigned keep;
  asm volatile("s_mov_b32 %0, m0\n\ts_mov_b32 m0, %2\n\ts_nop 0\n\tglobal_load_lds_dwordx4 %1, off\n\ts_mov_b32 m0, %0":"=&s"(keep):"v"(gsrc),"s"(lds_dst):"memory");}
__device__ __forceinline__ float max3f(float a,float b,float c){float r;asm("v_max3_f32 %0, %1, %2, %3":"=v"(r):"v"(a),"v"(b),"v"(c));return r;}
__device__ __forceinline__ float max2f(float a,float b){float r;asm("v_max_f32_e32 %0, %1, %2":"=v"(r):"v"(a),"v"(b));return r;}
__device__ __forceinline__ float fadd_s(float a,float b){float r;asm("v_add_f32_e32 %0, %1, %2":"=v"(r):"v"(a),"v"(b));return r;}
__device__ __forceinline__ float fsub_s(float a,float b){float r;asm("v_sub_f32_e32 %0, %1, %2":"=v"(r):"v"(a),"v"(b));return r;}
typedef float f32x2_t __attribute__((ext_vector_type(2))); typedef __bf16 bf16x2_t __attribute__((ext_vector_type(2)));
__device__ __forceinline__ unsigned cvtpk_s(float lo,float hi){f32x2_t v={lo,hi};bf16x2_t b=__builtin_convertvector(v,bf16x2_t);return __builtin_bit_cast(unsigned,b);}
#define WAIT_BAR(N) asm volatile("s_waitcnt vmcnt(" #N ") lgkmcnt(0)\n\ts_barrier":::"memory")

template<int ND0> __device__ __forceinline__ void qkt(f32x16&p0,f32x16&p1,lds_cptr Kslot,const bf16x8*qr,const f32x16&negm,int r32,int hi){
  lds_cptr kb=Kslot+hi*1024+r32*16;
  #pragma unroll
  for(int d0=0;d0<ND0;++d0){
    const bf16x8 b0=*(const LAS bf16x8*)(kb+d0*2048);
    const bf16x8 b1=*(const LAS bf16x8*)(kb+d0*2048+512);
    if(d0==0){p0=__builtin_amdgcn_mfma_f32_32x32x16_bf16(b0,qr[0],negm,0,0,0);p1=__builtin_amdgcn_mfma_f32_32x32x16_bf16(b1,qr[0],negm,0,0,0);}
    else{p0=__builtin_amdgcn_mfma_f32_32x32x16_bf16(b0,qr[d0],p0,0,0,0);p1=__builtin_amdgcn_mfma_f32_32x32x16_bf16(b1,qr[d0],p1,0,0,0);}}
}
template<int ND0> __device__ __forceinline__ void kloadN(bf16x8*kf,lds_cptr kp){
  #pragma unroll
  for(int j=0;j<ND0;++j){ kf[2*j]=*(const __attribute__((address_space(3))) bf16x8*)(kp+j*2048); kf[2*j+1]=*(const __attribute__((address_space(3))) bf16x8*)(kp+j*2048+512); }
}
__device__ __forceinline__ void kload2(bf16x8*kf,lds_cptr kp,int j){ kf[2*j]=*(const __attribute__((address_space(3))) bf16x8*)(kp+j*2048); kf[2*j+1]=*(const __attribute__((address_space(3))) bf16x8*)(kp+j*2048+512); }
__device__ __forceinline__ s16x4 vtr(lds_cptr p){ return __builtin_bit_cast(s16x4,__builtin_amdgcn_ds_read_tr16_b64_v4i16((__attribute__((address_space(3))) v4i16_t*)p)); }
__device__ __forceinline__ float rowmax(const f32x16&p0,const f32x16&p1){
  float a=max3f(p0[0],p0[1],p1[0]),b=max3f(p0[2],p0[3],p1[1]);a=max3f(a,p1[2],p1[3]);
  #pragma unroll
  for(int r=4;r<16;r+=4){a=max3f(a,p0[r],p0[r+1]);b=max3f(b,p0[r+2],p0[r+3]);a=max3f(a,p1[r],p1[r+1]);b=max3f(b,p1[r+2],p1[r+3]);}
  const float m=max2f(a,b);
  auto rr=__builtin_amdgcn_permlane32_swap(__float_as_uint(m),__float_as_uint(m),false,false);
  return max2f(__uint_as_float(rr[0]),__uint_as_float(rr[1]));
}
__device__ __forceinline__ void pv(f32x16*o,int vb,bf16x8 pa0,bf16x8 pa1,bf16x8 pa2,bf16x8 pa3){
  #pragma unroll
  for(int d0=0;d0<2;++d0){s16x4 lo[4],hi[4];
    #pragma unroll
    for(int ks=0;ks<4;++ks){
      asm volatile("ds_read_b64_tr_b16 %0,%1 offset:%c2":"=&v"(lo[ks]):"v"(vb),"i"(d0*4096+ks*1024):"memory");
      asm volatile("ds_read_b64_tr_b16 %0,%1 offset:%c2":"=&v"(hi[ks]):"v"(vb),"i"(d0*4096+ks*1024+512):"memory");}
    asm volatile("s_waitcnt lgkmcnt(0)":::"memory");SBAR();
    #define PK(k) (bf16x8){lo[k][0],lo[k][1],lo[k][2],lo[k][3],hi[k][0],hi[k][1],hi[k][2],hi[k][3]}
    o[d0]=__builtin_amdgcn_mfma_f32_32x32x16_bf16(pa0,PK(0),o[d0],0,0,0);
    o[d0]=__builtin_amdgcn_mfma_f32_32x32x16_bf16(pa1,PK(1),o[d0],0,0,0);
    o[d0]=__builtin_amdgcn_mfma_f32_32x32x16_bf16(pa2,PK(2),o[d0],0,0,0);
    o[d0]=__builtin_amdgcn_mfma_f32_32x32x16_bf16(pa3,PK(3),o[d0],0,0,0);
    #undef PK
  }
}

template<int THRL,int DQ,bool MOBA> __device__ __forceinline__ void attn_unit(int wave0,int b,int h,int qb,gcbf Q,gcbf K,gcbf V,gbf O,LAS unsigned char*shm,gcf32 kmp,gcf32 ropeB,gu32*qp,volatile LAS unsigned*nslot){
  constexpr int ND0=DQ/16, NCH=DQ/8, SLOTB=NCH*1024, LDQ=MOBA?512:768, LDK=LDQ;
  constexpr int LDS_K=0, LDS_V=NSLOT*SLOTB, LDS_WS=2*NSLOT*SLOTB, LDS_OST=LDS_WS+NW*64*4, LDS_END=LDS_OST+NW*4096;
  static_assert(LDS_END+4096<=131072,"attention LDS");
  const int tid=phase_tid(wave0),lane=tid&63,r32=lane&31,hi=lane>>5; const int wid=__builtin_amdgcn_readfirstlane(tid>>6);
  const bool kp2=(DQ>64)&&(wid<NCH-8);
  const long rowbase=(long)b*SEQ; const int q0=qb*QB;
  gcbf Qw=Q+(rowbase+q0+wid*QBLK)*LDQ+h*DQ;
  gcbf Kh=K+rowbase*LDK+h*DQ; gcbf Vh=V+rowbase*DM+h*D;
  const unsigned lds0=(unsigned)(uintptr_t)shm;
  LAS float*wsf=(LAS float*)(shm+LDS_WS)+wid*64; LAS float*kml=(LAS float*)(shm+LDS_END);
  gcbf ksrc=Kh+(long)lane*LDK+wid*8;
  gcbf vsrc=Vh+(long)(16*(wid&3)+(lane>>2))*DM+(wid>>2)*32+(lane&3)*8;
  const unsigned kdst=lds0+LDS_K+wid*1024, vdst=lds0+LDS_V+wid*1024;
  #define DMA_K(t,slot) do{ glds16(ksrc+(long)(t)*KVBLK*LDK,(unsigned)__builtin_amdgcn_readfirstlane(kdst+(slot))); \
      if(kp2) glds16(ksrc+(long)(t)*KVBLK*LDK+64,(unsigned)__builtin_amdgcn_readfirstlane(kdst+8192+(slot))); }while(0)
  #define DMA_V(t,slot) glds16(vsrc+(long)(t)*KVBLK*DM,(unsigned)__builtin_amdgcn_readfirstlane(vdst+(slot)))
  #define WB3() do{ if(kp2){WAIT_BAR(5);} else {WAIT_BAR(3);} }while(0)
  #define WB2() do{ if(kp2){WAIT_BAR(3);} else {WAIT_BAR(2);} }while(0)
  const int vb0=(int)(lds0+LDS_V)+((lane>>4)&1)*32+(lane&3)*8+(4*hi+((lane&15)>>2))*64;
  bf16x8 kf[2*ND0];
  const lds_cptr shm3=(lds_cptr)shm; const lds_cptr Kbase=shm3+LDS_K; const lds_cptr kp0=shm3+LDS_K+hi*1024+r32*16; const lds_cptr vp0=shm3+LDS_V+((lane>>4)&1)*32+(lane&3)*8+(4*hi+((lane&15)>>2))*64;
  const int NT=(q0+QB)/KVBLK;
  if constexpr(MOBA){ for(int i=tid;i<qb*64;i+=512){const int n=i>>6,d=i&63; kml[i]=(kmp[(size_t)n*1024+d]+kmp[(size_t)n*1024+512+d])*(1.f/256.f);} }
  DMA_K(0,0);DMA_V(0,0);DMA_K(1,SLOTB);
  bf16x8 qr[ND0];
  #pragma unroll
  for(int d0=0;d0<ND0;++d0)qr[d0]=*(const GAS bf16x8*)(Qw+(long)r32*LDQ+d0*16+hi*8);
  if constexpr(!MOBA){
    float qf[ND0][8]; float ss=0.f;
    #pragma unroll
    for(int d0=0;d0<ND0;++d0)
      #pragma unroll
      for(int j=0;j<8;++j){ qf[d0][j]=__uint_as_float(((unsigned)(unsigned short)qr[d0][j])<<16); ss+=qf[d0][j]*qf[d0][j]; }
    { auto rr=__builtin_amdgcn_permlane32_swap(__float_as_uint(ss),__float_as_uint(ss),false,false); ss=__uint_as_float(rr[0])+__uint_as_float(rr[1]); }
    const float rstd=1.0f/sqrtf(ss*(1.f/96.f)+EPS)*C2B;
    #pragma unroll
    for(int d0=0;d0<ND0;++d0)
      #pragma unroll
      for(int j=0;j<8;++j) qf[d0][j]*=rstd*kmp[d0*16+hi*8+j];
    const int pos=q0+wid*QBLK+r32;
    #pragma unroll
    for(int j=0;j<8;++j){ const float c=ropeB[pos*16+8*hi+j], s=ropeB[4096*16+pos*16+8*hi+j]; const float x1=qf[ND0-2][j], x2=qf[ND0-1][j]; qf[ND0-2][j]=x1*c-x2*s; qf[ND0-1][j]=x2*c+x1*s; }
    #pragma unroll
    for(int d0=0;d0<ND0;++d0){ u32x4 w; w[0]=cvtpk_s(qf[d0][0],qf[d0][1]); w[1]=cvtpk_s(qf[d0][2],qf[d0][3]); w[2]=cvtpk_s(qf[d0][4],qf[d0][5]); w[3]=cvtpk_s(qf[d0][6],qf[d0][7]); qr[d0]=__builtin_bit_cast(bf16x8,w); }
  }
  float mhat=0.f,l_reg=0.f;f32x16 o[2];o[0]=f32x16{};o[1]=f32x16{};f32x16 negm=f32x16{};asm volatile("":"+v"(negm));
  const int qrel=wid*QBLK+r32;
  #define NEGM_SET(tt) do{ if constexpr(MOBA){ float v_=-mhat; if((tt)<NT-4 && !((selmask>>((tt)>>2))&1u)) v_+=NEGB; _Pragma("unroll") for(int r=0;r<16;++r)negm[r]=v_; asm volatile("":"+v"(negm)); } }while(0)
  #define NEGM_NEXT(t) do{ if constexpr(MOBA){ if((((t)+1)&3)==0) NEGM_SET((t)+1); } }while(0)
  #define CMASK(P0,P1,t) do{int jb_=(t)-(NT-4); if(jb_>=0 && wid<2*jb_+2)cmask(P0,P1,jb_,qrel,hi);}while(0)
  bool resc=false;
  #define START(P0,P1) do{ const float rm=rowmax(P0,P1); resc=false; \
    { const float dl=max2f(rm,-1000.f); mhat=fadd_s(mhat,dl); \
      _Pragma("unroll") for(int r=0;r<16;++r){P0[r]=fsub_s(P0[r],dl);P1[r]=fsub_s(P1[r],dl);} \
      _Pragma("unroll") for(int r=0;r<16;++r)negm[r]=-mhat; asm volatile("":"+v"(negm)); } \
    _Pragma("unroll") for(int r=0;r<16;++r)P0[r]=__builtin_amdgcn_exp2f(P0[r]); }while(0)
  #define RESC() do{ if(resc){ asm volatile("s_waitcnt lgkmcnt(0)":::"memory"); \
      _Pragma("unroll") for(int d_=0;d_<2;++d_) _Pragma("unroll") for(int r=0;r<16;++r)o[d_][r]*=wsf[crow(r,hi)]; } }while(0)
  f32x16 pA0,pA1,pB0,pB1;
  int sl_prev=0,sl_cur=0,sl_next=SLOTB;
  #define ROT() do{sl_prev=sl_cur;sl_cur=sl_next;sl_next=(sl_next==(NSLOT-1)*SLOTB)?0:sl_next+SLOTB;}while(0)
  DMA_K(2,2*SLOTB);
  WB3();
  unsigned selmask=0xffffffffu;
  if constexpr(MOBA){
  if(qb<=3) selmask=(1u<<qb)-1u;
  else{ float b1=-INFINITY,b2=-INFINITY,b3=-INFINITY; int i1=0,i2=0,i3=0;
    for(int n=0;n<qb;++n){ float g=0.f;
      _Pragma("unroll") for(int d0=0;d0<4;++d0) _Pragma("unroll") for(int j=0;j<8;++j) g+=__uint_as_float(((unsigned)(unsigned short)qr[d0][j])<<16)*kml[n*64+d0*16+hi*8+j];
      { auto rr=__builtin_amdgcn_permlane32_swap(__float_as_uint(g),__float_as_uint(g),false,false); g=__uint_as_float(rr[0])+__uint_as_float(rr[1]); }
      if(g>b1){b3=b2;i3=i2;b2=b1;i2=i1;b1=g;i1=n;} else if(g>b2){b3=b2;i3=i2;b2=g;i2=n;} else if(g>b3){b3=g;i3=n;} }
    selmask=(1u<<i1)|(1u<<i2)|(1u<<i3); }
  }
  NEGM_SET(0);
  qkt<ND0>(pA0,pA1,Kbase,qr,negm,r32,hi);asm volatile("s_nop 15\n\ts_nop 7":"+v"(pA0),"+v"(pA1));CMASK(pA0,pA1,0);
  START(pA0,pA1);
  NEGM_SET(1);
  _Pragma("unroll") for(int r=0;r<16;++r)pA1[r]=__builtin_amdgcn_exp2f(pA1[r]);
  WAIT_BAR(0);
  DMA_K(3,0);DMA_V(1,SLOTB);
  ROT();
  kloadN<ND0>(kf,kp0+sl_cur);
  WB2();
  s16x4 vlo[8],vhi[8]; u32x4 pw0,pw1,pw2,pw3;
  #define PKW(P,B) cvtpk_s(P[B],P[B+1])
  #define PAF(k) __builtin_bit_cast(bf16x8,pw##k)
  #define VFR(i) (bf16x8){vlo[i][0],vlo[i][1],vlo[i][2],vlo[i][3],vhi[i][0],vhi[i][1],vhi[i][2],vhi[i][3]}
  #define PIN(x) asm volatile("":"+v"(x))
  #define MX3(a,b,c) __builtin_fmaxf(__builtin_fmaxf((a),(b)),(c))
  #define GAPA(MF,A0,A1,A2,A3,W0,W1,PW) do{ MF; sacc+=A0; sacc+=A1; sacc+=A2; sacc+=A3; PIN(sacc); W0; W1; PIN(PW); SBAR(); }while(0)
  #define EX(v) __builtin_amdgcn_exp2f(v)
  #define GAPB(MF,X,B) do{ MF; X[B]=EX(X[B]); X[B+1]=EX(X[B+1]); X[B+2]=EX(X[B+2]); X[B+3]=EX(X[B+3]); PIN(X); SBAR(); }while(0)
  #define VRD(i) do{ vlo[i]=vtr(vp_+(((i)>>2)*4096+((i)&3)*1024)); vhi[i]=vtr(vp_+(((i)>>2)*4096+((i)&3)*1024+512)); }while(0)
  #define KRD(G,j) do{ if(G){ kload2(kf,kp0+sl_next,j); SBAR(); } }while(0)
  #define STEP(C0,C1,P0,P1,t,GK,GV,GL) do{ SBAR(); \
    const lds_cptr vp_=vp0+sl_prev; \
    VRD(0); SBAR(); float sacc=(P0[0]+P0[1]); \
    GAPA(C0=__builtin_amdgcn_mfma_f32_32x32x16_bf16(kf[0],qr[0],negm,0,0,0), P0[2],P0[3],P0[4],P0[5],     pw0[0]=PKW(P0,0), pw0[1]=PKW(P0,2), pw0); \
    VRD(4); SBAR(); GAPA(C1=__builtin_amdgcn_mfma_f32_32x32x16_bf16(kf[1],qr[0],negm,0,0,0), P0[6],P0[7],P0[8],P0[9],     pw0[2]=PKW(P0,4), pw0[3]=PKW(P0,6), pw0); \
    VRD(1); SBAR(); GAPA(C0=__builtin_amdgcn_mfma_f32_32x32x16_bf16(kf[2],qr[1],C0,0,0,0),   P0[10],P0[11],P0[12],P0[13], pw1[0]=PKW(P0,8), pw1[1]=PKW(P0,10), pw1); \
    VRD(5); SBAR(); GAPA(C1=__builtin_amdgcn_mfma_f32_32x32x16_bf16(kf[3],qr[1],C1,0,0,0),   P0[14],P0[15],P1[0],P1[1],   pw1[2]=PKW(P0,12),pw1[3]=PKW(P0,14), pw1); \
    VRD(2); SBAR(); GAPA(C0=__builtin_amdgcn_mfma_f32_32x32x16_bf16(kf[4],qr[2],C0,0,0,0),   P1[2],P1[3],P1[4],P1[5],     pw2[0]=PKW(P1,0), pw2[1]=PKW(P1,2), pw2); \
    VRD(6); SBAR(); GAPA(C1=__builtin_amdgcn_mfma_f32_32x32x16_bf16(kf[5],qr[2],C1,0,0,0),   P1[6],P1[7],P1[8],P1[9],     pw2[2]=PKW(P1,4), pw2[3]=PKW(P1,6), pw2); \
    VRD(3); SBAR(); GAPA(C0=__builtin_amdgcn_mfma_f32_32x32x16_bf16(kf[6],qr[3],C0,0,0,0),   P1[10],P1[11],P1[12],P1[13], pw3[0]=PKW(P1,8), pw3[1]=PKW(P1,10), pw3); \
    VRD(7); SBAR(); GAPA(C1=__builtin_amdgcn_mfma_f32_32x32x16_bf16(kf[7],qr[3],C1,0,0,0),   P1[14],P1[15],0.f,0.f,       pw3[2]=PKW(P1,12),pw3[3]=PKW(P1,14), pw3); \
    if constexpr(ND0==6){ C0=__builtin_amdgcn_mfma_f32_32x32x16_bf16(kf[2*ND0-4],qr[ND0-2],C0,0,0,0); C1=__builtin_amdgcn_mfma_f32_32x32x16_bf16(kf[2*ND0-3],qr[ND0-2],C1,0,0,0); \
      C0=__builtin_amdgcn_mfma_f32_32x32x16_bf16(kf[2*ND0-2],qr[ND0-1],C0,0,0,0); C1=__builtin_amdgcn_mfma_f32_32x32x16_bf16(kf[2*ND0-1],qr[ND0-1],C1,0,0,0); SBAR(); } \
    l_reg+=sacc; \
    if(GK){DMA_K((t)+3,sl_cur);} if(GV){DMA_V((t)+1,sl_next);} \
    CMASK(C0,C1,t); \
    { float a=MX3(C0[0],C0[1],C1[0]),b=MX3(C0[2],C0[3],C1[1]); a=MX3(a,C1[2],C1[3]); \
      _Pragma("unroll") for(int r=4;r<16;r+=4){a=MX3(a,C0[r],C0[r+1]);b=MX3(b,C0[r+2],C0[r+3]);a=MX3(a,C1[r],C1[r+1]);b=MX3(b,C1[r+2],C1[r+3]);} \
      float rm=__builtin_fmaxf(a,b); { auto rr=__builtin_amdgcn_permlane32_swap(__float_as_uint(rm),__float_as_uint(rm),false,false); rm=__builtin_fmaxf(__uint_as_float(rr[0]),__uint_as_float(rr[1])); } \
      resc=false; \
      if(__builtin_expect(__any(rm>(float)THRL),0)){ const float dl=__builtin_fmaxf(rm,0.f); \
          \
        const bool live_=MOBA?(dl>0.f&&l_reg>0.f):true; mhat+=dl; \
        _Pragma("unroll") for(int r=0;r<16;++r){C0[r]-=dl;C1[r]-=dl;} \
        if constexpr(MOBA){ NEGM_SET((t)+1); } else { _Pragma("unroll") for(int r=0;r<16;++r)negm[r]=-mhat; asm volatile("":"+v"(negm)); } \
        const float f=__builtin_amdgcn_exp2f(-dl); l_reg*=f; if(hi==0)wsf[r32]=f; resc=MOBA?(bool)__any(live_):true; } } \
    SBAR(); \
    GAPB(o[0]=__builtin_amdgcn_mfma_f32_32x32x16_bf16(PAF(0),VFR(0),o[0],0,0,0), C0,0); \
    if constexpr(ND0==6){ KRD(GL,ND0-2); } GAPB(o[1]=__builtin_amdgcn_mfma_f32_32x32x16_bf16(PAF(0),VFR(4),o[1],0,0,0), C0,4); \
    KRD(GL,0); GAPB(o[0]=__builtin_amdgcn_mfma_f32_32x32x16_bf16(PAF(1),VFR(1),o[0],0,0,0), C0,8); \
    KRD(GL,1); GAPB(o[1]=__builtin_amdgcn_mfma_f32_32x32x16_bf16(PAF(1),VFR(5),o[1],0,0,0), C0,12); \
    KRD(GL,2); GAPB(o[0]=__builtin_amdgcn_mfma_f32_32x32x16_bf16(PAF(2),VFR(2),o[0],0,0,0), C1,0); \
    KRD(GL,3); GAPB(o[1]=__builtin_amdgcn_mfma_f32_32x32x16_bf16(PAF(2),VFR(6),o[1],0,0,0), C1,4); \
    if constexpr(ND0==6){ KRD(GL,ND0-1); } GAPB(o[0]=__builtin_amdgcn_mfma_f32_32x32x16_bf16(PAF(3),VFR(3),o[0],0,0,0), C1,8); \
    GAPB(o[1]=__builtin_amdgcn_mfma_f32_32x32x16_bf16(PAF(3),VFR(7),o[1],0,0,0), C1,12); \
    }while(0)
  int t=1;
  #undef CMASK
  #define CMASK(P0,P1,t) do{}while(0)
  for(;t+5<NT;t+=2){
    STEP(pB0,pB1,pA0,pA1,t,true,true,true);     WB2(); RESC(); NEGM_NEXT(t);   ROT();
    STEP(pA0,pA1,pB0,pB1,t+1,true,true,true);   WB2(); RESC(); NEGM_NEXT(t+1); ROT();
  }
  #undef CMASK
  #define CMASK(P0,P1,t) do{int jb_=(t)-(NT-4); if(jb_>=0 && wid<2*jb_+2)cmask(P0,P1,jb_,qrel,hi);}while(0)
  #define ENDW(tt) do{ if((tt)+3<NT){WB2();} else if((tt)+2<NT){WAIT_BAR(1);} else {WAIT_BAR(0);} }while(0)
  for(;t+1<NT;t+=2){
    STEP(pB0,pB1,pA0,pA1,t,(t+3<NT),(t+1<NT),(t+1<NT));       ENDW(t);   RESC(); NEGM_NEXT(t);   ROT();
    STEP(pA0,pA1,pB0,pB1,t+1,(t+4<NT),(t+2<NT),(t+2<NT));     ENDW(t+1); RESC(); ROT();
  }
  STEP(pB0,pB1,pA0,pA1,NT-1,false,false,false); RESC();
  unsigned nxv=0u; if(tid==0)nxv=__hip_atomic_fetch_add(qp,1u,__ATOMIC_RELAXED,__HIP_MEMORY_SCOPE_AGENT);
  { float sacc=pB0[0]+pB0[1]; _Pragma("unroll") for(int r=2;r<16;++r)sacc+=pB0[r]; _Pragma("unroll") for(int r=0;r<16;++r)sacc+=pB1[r]; l_reg+=sacc;
    pw0=(u32x4){PKW(pB0,0),PKW(pB0,2),PKW(pB0,4),PKW(pB0,6)};pw1=(u32x4){PKW(pB0,8),PKW(pB0,10),PKW(pB0,12),PKW(pB0,14)};pw2=(u32x4){PKW(pB1,0),PKW(pB1,2),PKW(pB1,4),PKW(pB1,6)};pw3=(u32x4){PKW(pB1,8),PKW(pB1,10),PKW(pB1,12),PKW(pB1,14)};
    SBAR(); pv(o,vb0+sl_cur,PAF(0),PAF(1),PAF(2),PAF(3)); }
  #undef PKW
  #undef PAF
  #undef VFR
  #undef PIN
  #undef MX3
  #undef GAPA
  #undef GAPB
  #undef EX
  #undef VRD
  #undef KRD
  #undef STEP
  #undef ENDW
  {auto rr=__builtin_amdgcn_permlane32_swap(__float_as_uint(l_reg),__float_as_uint(l_reg),false,false);l_reg=__uint_as_float(rr[0])+__uint_as_float(rr[1]);}
  if(hi==0)wsf[32+r32]=l_reg;asm volatile("s_waitcnt lgkmcnt(0)":::"memory");
  float rli[16];
  #pragma unroll
  for(int r=0;r<16;++r)rli[r]=__builtin_amdgcn_rcpf(wsf[32+crow(r,hi)]);
  gbf Ow=O+(rowbase+q0+wid*QBLK)*DM+h*D;
  { LAS unsigned short*stg=(LAS unsigned short*)(shm+LDS_OST)+wid*2048;
    #pragma unroll
    for(int r=0;r<16;++r){const int orow=crow(r,hi);
      #pragma unroll
      for(int d0=0;d0<2;++d0)stg[orow*64+d0*32+r32]=(unsigned short)(cvtpk_s(o[d0][r]*rli[r],0.f)&0xffffu);}
    asm volatile("s_waitcnt lgkmcnt(0)":::"memory");
    #pragma unroll
    for(int i=0;i<4;++i){const int row=i*8+(lane>>3),ch=lane&7; const u32x4 v=*(const LAS u32x4*)(stg+row*64+ch*8); *(GAS u32x4*)(Ow+(long)row*DM+ch*8)=v;} }
  if(tid==0)*nslot=nxv;
  asm volatile("s_waitcnt lgkmcnt(0)\n\ts_barrier":::"memory");
  #undef DMA_K
  #undef DMA_V
  #undef WB2
  #undef WB3
  #undef CMASK
  #undef START
  #undef RESC
  #undef ROT
  #undef NEGM_SET
  #undef NEGM_NEXT
}
#undef SBAR
#undef WAIT_BAR
}

#define XB_TMO      128
#define XB_XCNT(j)  (256  + 64 * (j))
#define XB_XSUB(j)  (1280 + 64 * (j))
#define XB_XGEN(j)  (2304 + 64 * (j))
#define XB_TOP      3328
#define XB_TOPGEN   3392
#define XCD_BAR_WORDS 3456
#define XB_SPIN_CAP (1u << 18)
__device__ __forceinline__ unsigned xb_ld(unsigned* p)              { return __hip_atomic_load(p, __ATOMIC_RELAXED, __HIP_MEMORY_SCOPE_AGENT); }
__device__ __forceinline__ unsigned xb_add(unsigned* p, unsigned v) { return __hip_atomic_fetch_add(p, v, __ATOMIC_RELAXED, __HIP_MEMORY_SCOPE_AGENT); }
__device__ __forceinline__ unsigned xb_xcc_id() { return (unsigned)__builtin_amdgcn_s_getreg((3 << 11) | 20) & 0xFu; }
#define XB_SPIN(cond, bar) do { unsigned _sp = 0; while (cond) { __builtin_amdgcn_s_sleep(1); \
    if ((++_sp & 255u) == 0u) { if (xb_ld(&(bar)[XB_TMO])) break; if (_sp > XB_SPIN_CAP) { atomicAdd(&(bar)[XB_TMO], 1u); break; } } } } while (0)
struct XcdBarrier { unsigned* bar; unsigned x; volatile LAS unsigned* st; };
__device__ __forceinline__ XcdBarrier xcd_barrier_post(unsigned* bar, volatile LAS unsigned* st) {
    XcdBarrier b; b.bar = bar; b.x = xb_xcc_id(); b.st = st;
    if (threadIdx.x == 0) (void)xb_add(&bar[XB_XCNT(b.x)], 1u);
    return b;
}
__device__ __forceinline__ void xcd_barrier_complete(unsigned* bar, unsigned x, unsigned& nloc, unsigned& nx) {
    const unsigned G = gridDim.x * gridDim.y * gridDim.z;
    unsigned sum, cnt, mine, sp = 0u;
    for (;;) {
        sum = 0u; cnt = 0u; mine = 0u;
#pragma unroll
        for (unsigned j = 0; j < 16; ++j) { const unsigned c = xb_ld(&bar[XB_XCNT(j)]); sum += c; cnt += (c > 0u) ? 1u : 0u; mine = (j == x) ? c : mine; }
        if (sum == G) break;
        __builtin_amdgcn_s_sleep(1);
        if ((++sp & 255u) == 0u) { if (xb_ld(&bar[XB_TMO])) break; if (sp > XB_SPIN_CAP) { atomicAdd(&bar[XB_TMO], 1u); break; } }
    }
    nloc = mine > 0u ? mine : 1u; nx = cnt > 0u ? cnt : 1u;
}
__device__ __forceinline__ void xcd_barrier(const XcdBarrier& b, int wave0) {
    asm volatile("s_waitcnt vmcnt(0)" ::: "memory");
    __syncthreads();
    if (phase_tid(wave0) == 0) {
        unsigned* bar = b.bar; asm volatile("" : "+s"(bar));
        __builtin_amdgcn_s_waitcnt(0);
        unsigned nloc = b.st[0], nx = b.st[1];
        unsigned bx = b.x; asm volatile("" : "+s"(bx));
        if (nloc == 0u) { xcd_barrier_complete(bar, bx, nloc, nx); b.st[0] = nloc; b.st[1] = nx; }
        const unsigned old = xb_add(&bar[XB_XSUB(bx)], 1u);
        const unsigned gen = old / nloc;
        if (old + 1u == (gen + 1u) * nloc) {
            __builtin_amdgcn_fence(__ATOMIC_RELEASE, "agent");
            asm volatile("s_waitcnt vmcnt(0)" ::: "memory");
            const unsigned og = xb_add(&bar[XB_TOP], 1u);
            const unsigned tg = og / nx;
            if (og + 1u == (tg + 1u) * nx) xb_add(&bar[XB_TOPGEN], 1u);
            else XB_SPIN(xb_ld(&bar[XB_TOPGEN]) == tg, bar);
            __builtin_amdgcn_fence(__ATOMIC_ACQUIRE, "agent");
            xb_add(&bar[XB_XGEN(bx)], 1u);
            asm volatile("s_waitcnt vmcnt(0)" ::: "memory");
        } else {
            XB_SPIN(xb_ld(&bar[XB_XGEN(bx)]) == gen, bar);
            __builtin_amdgcn_fence(__ATOMIC_ACQUIRE, "agent");
            asm volatile("s_waitcnt vmcnt(0)" ::: "memory");
        }
    }
    __syncthreads();
}

struct Args { const float* in[20]; float* out; unsigned char* ws; int ph_lo, ph_hi; };
struct Frame {
    LAS unsigned char* lds; volatile LAS unsigned* MISC;
    int G, NGW;
    unsigned char* ws;
};
#define PH_IDS const int tid = phase_tid(wave0); const int lane = tid & 63, wave = __builtin_amdgcn_readfirstlane(tid >> 6), gw = (int)blockIdx.x * NWAVES + wave; (void)lane; (void)gw; \
    gws_t ws = (gws_t)args.ws; asm volatile("" : "+s"(ws)); gu32* const ctl = (gu32*)ws; (void)ctl; \
    int bid = (int)blockIdx.x; asm volatile("" : "+s"(bid)); int Gl = F.G; asm volatile("" : "+s"(Gl)); const int NGWl = Gl * NWAVES; (void)NGWl
constexpr int NWAVES = 8;

__device__ __forceinline__ int maprow(int mode, int n) {
    if (mode == 1) {
        if (n >= 2208) return n + 96;
        if (n >= 1024) return n;
        const int reg = n >> 9, o = n & 511, head = o >> 6, dim = o & 63, sg = dim >> 3;
        return reg * 512 + 256 * (head >> 2) + 128 * (sg & 1) + 32 * (head & 3) + 8 * (sg >> 1) + 4 * ((dim >> 2) & 1) + (dim & 3);
    }
    if (mode == 2) { const int nn = n >= DFF ? 1 : 0, a = n - nn * DFF, pn = a >> 7, r = a & 127; return 256 * pn + 128 * nn + r; }
    if (mode == 3) {
        const int h = n >> 7, j = n & 127;
        if (j >= 64) return 512 + h * 64 + (j - 64);
        return 256 * (h >> 2) + 128 * (j >> 5) + 32 * (h & 3) + (j & 31);
    }
    return n;
}
__device__ __forceinline__ void transpose_load(gcf32 W, int N, int nblk, int item, int lane, float* wv) {
    const int kb = item / nblk, nb = item % nblk, k0 = 64 * kb, n0 = 32 * nb;
#pragma unroll
    for (int i = 0; i < 32; ++i) { const int kk = 2 * i + (lane >> 5); wv[i] = W[(size_t)(k0 + kk) * N + n0 + (lane & 31)]; }
}
__device__ __forceinline__ void transpose_store(float* wv, int K, int N, gbf WT, int mode, LAS float* scr, int item, int lane, gcf32 kgain, float allscale = 1.f) {
    const int nblk = N / 32, kb = item / nblk, nb = item % nblk, k0 = 64 * kb, n0 = 32 * nb;
    { const float sc = allscale * (((mode == 1 && n0 >= 2208) || (mode == 2 && n0 < DFF)) ? -LOG2E : 1.f);
      if (sc != 1.f) {
#pragma unroll
        for (int i = 0; i < 32; ++i) wv[i] *= sc; } }
    if (kgain) {
#pragma unroll
        for (int i = 0; i < 32; ++i) wv[i] *= kgain[k0 + 2 * i + (lane >> 5)]; }
#pragma unroll
    for (int i = 0; i < 32; ++i) { const int kk = 2 * i + (lane >> 5); scr[kk * 33 + (lane & 31)] = wv[i]; }
    LDS_WAIT(); asm volatile("" ::: "memory");
    const int c = lane & 7;
#pragma unroll
    for (int j = 0; j < 4; ++j) { const int n = (lane >> 3) + 8 * j; const LAS float* s = scr + (8 * c) * 33 + n;
        v4u o; o.x = cvt_pk_bf16(s[0 * 33], s[1 * 33]); o.y = cvt_pk_bf16(s[2 * 33], s[3 * 33]); o.z = cvt_pk_bf16(s[4 * 33], s[5 * 33]); o.w = cvt_pk_bf16(s[6 * 33], s[7 * 33]);
        *(GAS v4u*)(WT + (size_t)maprow(mode, n0 + n) * K + k0 + 8 * c) = o; }
    LDS_WAIT(); asm volatile("" ::: "memory");
}
__device__ __forceinline__ void conv_job(Frame& F, int NGW, int lane, int wave, int gw, gcf32 W, int K, int N, gbf WT, int mode, int& rot, gcf32 kgain = nullptr, float allscale = 1.f) {
    LAS float* scr = (LAS float*)(F.lds + wave * 16384);
    const int nitems = (K / 64) * (N / 32);
    int start = gw - rot; if (start < 0) start += NGW;
    const int nblk = N / 32;
    for (int it = start; it < nitems; it += 2 * NGW) {
        const int it2 = it + NGW; const bool two = it2 < nitems;
        float wa[32], wb[32];
        transpose_load(W, N, nblk, it, lane, wa); transpose_load(W, N, nblk, two ? it2 : it, lane, wb);
        transpose_store(wa, K, N, WT, mode, scr, it, lane, kgain, allscale);
        if (two) transpose_store(wb, K, N, WT, mode, scr, it2, lane, kgain, allscale);
    }
    rot = (rot + nitems) % NGW;
}

__device__ __forceinline__ void unpack8(v4u w, float* f) { f[0] = bf_lo(w.x); f[1] = bf_hi(w.x); f[2] = bf_lo(w.y); f[3] = bf_hi(w.y); f[4] = bf_lo(w.z); f[5] = bf_hi(w.z); f[6] = bf_lo(w.w); f[7] = bf_hi(w.w); }
__device__ __forceinline__ void rms_row_to_bf16(gcf32 xrow, gcf32 g, gbf orow, int lane) {
    const GAS f32x4* xr = (const GAS f32x4*)xrow + lane; const GAS f32x4* gr = (const GAS f32x4*)g + lane;
    f32x4 v[4]; float s = 0.f;
#pragma unroll
    for (int j = 0; j < 4; ++j) { v[j] = xr[64 * j]; s += (v[j].x * v[j].x + v[j].y * v[j].y) + (v[j].z * v[j].z + v[j].w * v[j].w); }
    const float rstd = 1.0f / sqrtf(wave_sum(s, lane) * (1.f / D) + EPS);
    GAS unsigned long long* o8 = (GAS unsigned long long*)orow + lane;
#pragma unroll
    for (int j = 0; j < 4; ++j) { const f32x4 gg = gr[64 * j];
        o8[64 * j] = (unsigned long long)cvt_pk_bf16(v[j].x * rstd * gg.x, v[j].y * rstd * gg.y) | ((unsigned long long)cvt_pk_bf16(v[j].z * rstd * gg.z, v[j].w * rstd * gg.w) << 32); }
}
__device__ __forceinline__ void rms_rows_bf16in(gcbf x, gcf32 g, gbf o, int m0, int ms, int lane) {
    f32x4 gg[2][2];
#pragma unroll
    for (int j = 0; j < 2; ++j) { gg[j][0] = *(const GAS f32x4*)(g + 512 * j + 8 * lane); gg[j][1] = *(const GAS f32x4*)(g + 512 * j + 8 * lane + 4); }
    for (int m = m0; m < M; m += 4 * ms) {
        v4u v[4][2];
#pragma unroll
        for (int r = 0; r < 4; ++r) { const int mr = (m + r * ms < M) ? m + r * ms : m;
#pragma unroll
            for (int j = 0; j < 2; ++j) v[r][j] = *(const GAS v4u*)(x + (size_t)mr * D + 512 * j + 8 * lane); }
#pragma unroll
        for (int r = 0; r < 4; ++r) { const int mr = m + r * ms;
            if (mr < M) { float f[2][8]; float s = 0.f;
#pragma unroll
                for (int j = 0; j < 2; ++j) { unpack8(v[r][j], f[j]);
#pragma unroll
                    for (int e = 0; e < 8; ++e) s += f[j][e] * f[j][e]; }
                const float rstd = 1.0f / sqrtf(wave_sum(s, lane) * (1.f / D) + EPS);
#pragma unroll
                for (int j = 0; j < 2; ++j) { v4u w;
                    w.x = cvt_pk_bf16(f[j][0] * rstd * gg[j][0][0], f[j][1] * rstd * gg[j][0][1]); w.y = cvt_pk_bf16(f[j][2] * rstd * gg[j][0][2], f[j][3] * rstd * gg[j][0][3]);
                    w.z = cvt_pk_bf16(f[j][4] * rstd * gg[j][1][0], f[j][5] * rstd * gg[j][1][1]); w.w = cvt_pk_bf16(f[j][6] * rstd * gg[j][1][2], f[j][7] * rstd * gg[j][1][3]);
                    *(GAS v4u*)(o + (size_t)mr * D + 512 * j + 8 * lane) = w; } } }
    }
}
__device__ __forceinline__ void rms_rows_to_bf16(gcf32 x, gcf32 g, gbf o, int m0, int ms, int lane) {
    const GAS f32x4* gr = (const GAS f32x4*)g + lane; f32x4 gg[4];
#pragma unroll
    for (int j = 0; j < 4; ++j) gg[j] = gr[64 * j];
    for (int m = m0; m < M; m += 4 * ms) {
        f32x4 v[4][4];
#pragma unroll
        for (int r = 0; r < 4; ++r) { const int mr = (m + r * ms < M) ? m + r * ms : m; const GAS f32x4* xr = (const GAS f32x4*)(x + (size_t)mr * D) + lane;
#pragma unroll
            for (int j = 0; j < 4; ++j) v[r][j] = xr[64 * j]; }
#pragma unroll
        for (int r = 0; r < 4; ++r) { const int mr = m + r * ms;
            if (mr < M) {
            float s = 0.f;
#pragma unroll
            for (int j = 0; j < 4; ++j) s += (v[r][j].x * v[r][j].x + v[r][j].y * v[r][j].y) + (v[r][j].z * v[r][j].z + v[r][j].w * v[r][j].w);
            const float rstd = 1.0f / sqrtf(wave_sum(s, lane) * (1.f / D) + EPS);
            GAS unsigned long long* o8 = (GAS unsigned long long*)(o + (size_t)mr * D) + lane;
#pragma unroll
            for (int j = 0; j < 4; ++j)
                o8[64 * j] = (unsigned long long)cvt_pk_bf16(v[r][j].x * rstd * gg[j].x, v[r][j].y * rstd * gg[j].y) | ((unsigned long long)cvt_pk_bf16(v[r][j].z * rstd * gg[j].z, v[r][j].w * rstd * gg[j].w) << 32); } }
    }
}
__device__ __forceinline__ v4u pack8(const float* f) { v4u w; w.x = cvt_pk_bf16(f[0], f[1]); w.y = cvt_pk_bf16(f[2], f[3]); w.z = cvt_pk_bf16(f[4], f[5]); w.w = cvt_pk_bf16(f[6], f[7]); return w; }

constexpr int PH_PER_LAYER = 12, NPH = 1 + 2 * PH_PER_LAYER;

__global__ void __launch_bounds__(NWAVES * 64, 2) mk_fwd(Args args) {
    extern __shared__ __attribute__((aligned(16))) unsigned char lds_raw[];
    Frame F;
    F.lds = (LAS unsigned char*)lds_raw;
    F.MISC = (volatile LAS unsigned*)(F.lds + MISC_OFF);
    F.G = gridDim.x; F.NGW = F.G * NWAVES;
    const int wave0 = __builtin_amdgcn_readfirstlane((int)threadIdx.x >> 6);
    F.ws = args.ws;
    for (int u = threadIdx.x; u < (LDS_BYTES - LDSCTL_OFF) / 4; u += NWAVES * 64) ((LAS unsigned*)(F.lds + LDSCTL_OFF))[u] = 0u;
    __syncthreads();
    XcdBarrier bar = xcd_barrier_post((unsigned*)((gu32*)args.ws + CW_BAR), F.MISC + 8);
    const int lo = args.ph_lo, hi = args.ph_hi;
#define KIN(i) ({ const unsigned char* kp_ = (const unsigned char*)__builtin_amdgcn_kernarg_segment_ptr(); asm volatile("" : "+s"(kp_)); (gcf32)*(const GAS unsigned long long*)(kp_ + 8 * (i)); })
#define RUN(id) ({ int lo_ = lo, hi_ = hi; asm volatile("" : "+s"(lo_), "+s"(hi_)); lo_ <= (id) && (id) < hi_; })
#define SEAM(id) do { int hi_ = hi; asm volatile("" : "+s"(hi_)); if ((id) + 1 < hi_) xcd_barrier(bar, wave0); } while (0)

#define OUT   ((gf32)args.out)
#define HN    ((gbf)args.out)
#define XB    ((gbf)(ws + WS_XB))
#define QA    ((gbf)(ws + WS_QA))
#define KA    ((gbf)(ws + WS_KA))
#define VA    ((gbf)(ws + WS_VA))
#define LAT   ((gbf)(ws + WS_LAT))
#define GATES ((gbf)(ws + WS_GATES))
#define QB    ((gbf)(ws + WS_QB))
#define VB    ((gbf)(ws + WS_KVR))
#define KB    ((gbf)(ws + WS_KB))
#define YB    ((gbf)(ws + WS_YB))
#define YA    ((gbf)(ws + WS_YA))
#define KMEAN ((gf32)(ws + WS_KMEAN))
#define cosA  ((gf32)(ws + WS_ROPE))
#define sinA  (cosA + 4096 * 8)
#define cosB  (sinA + 4096 * 8)
#define sinB  (cosB + 4096 * 16)
#define ELIST ((GAS int*)(ws + WS_ELIST))
#define TOKP  ((gf32)(ws + WS_TOKP))

    if (RUN(0)) {
        PH_IDS;
        int rot = 0;
        for (int l = 0; l < 2; ++l) {
            gws_t wl = ws + WS_WL + l * WL_STRIDE;
            conv_job(F, NGWl, lane, wave, gw, KIN(2) + (size_t)l * D * INW, D, INW, (gbf)(wl + WL_IN), 1, rot);
            conv_job(F, NGWl, lane, wave, gw, KIN(6) + (size_t)l * QRANK * 768, QRANK, 768, (gbf)(wl + WL_UQ), 0, rot, KIN(5) + l * QRANK);
            conv_job(F, NGWl, lane, wave, gw, KIN(8) + (size_t)l * KVRANK * 1024, KVRANK, 1024, (gbf)(wl + WL_UKV), 3, rot, KIN(7) + l * KVRANK);
            conv_job(F, NGWl, lane, wave, gw, KIN(11) + (size_t)l * AW * D, AW, D, (gbf)(wl + WL_BRA), 0, rot);
            conv_job(F, NGWl, lane, wave, gw, KIN(12) + (size_t)l * AW * D, AW, D, (gbf)(wl + WL_BRB), 0, rot);
            conv_job(F, NGWl, lane, wave, gw, KIN(13) + (size_t)l * D * D, D, D, (gbf)(wl + WL_OUT), 0, rot);
            { GAS v4u* z = (GAS v4u*)(wl + WL_IN + (size_t)2208 * D * 2); const int nz = 96 * D * 2 / 16;
              for (int i = bid * 512 + tid; i < nz; i += Gl * 512) z[i] = (v4u){0u, 0u, 0u, 0u}; }
        }
        conv_job(F, NGWl, lane, wave, gw, KIN(15), D, 2 * DFF, (gbf)(ws + WS_WGU), 2, rot);
        conv_job(F, NGWl, lane, wave, gw, KIN(16), DFF, D, (gbf)(ws + WS_WDN), 0, rot, nullptr, -0.6931471805599453f);
        { gcf32 g = KIN(1); gcf32 xin = KIN(0);
          rms_rows_to_bf16(xin, g, HN, gw, NGWl, lane); }
        for (int i = bid * 512 + tid; i < 4096 * 24; i += Gl * 512) {
            const int pos = i / 24, j = i % 24;
            if (j < 8) { const float inv = (float)pow(500000.0, -(double)(2 * j) / 16.0); const float ang = (float)pos * inv; cosA[pos * 8 + j] = (float)cos((double)ang); sinA[pos * 8 + j] = (float)sin((double)ang); }
            else { const int jj = j - 8; const float inv = (float)pow(500000.0, -(double)(2 * jj) / 32.0); const float ang = (float)pos * inv; cosB[pos * 16 + jj] = (float)cos((double)ang); sinB[pos * 16 + jj] = (float)sin((double)ang); }
        }
        SEAM(0);
    }

    for (int l = 0; l < 2; ++l) {
        const int pb = 1 + l * PH_PER_LAYER;
#define WLP (ws + WS_WL + (size_t)l * WL_STRIDE)

        if (l == 1 && RUN(pb + 0)) {
            PH_IDS;
            gcf32 g = KIN(1) + l * D;
            rms_rows_bf16in(XB, g, HN, gw, NGWl, lane);
            SEAM(pb + 0);
        }
        if (RUN(pb + 1)) {
            PH_IDS;
            pg8::SchedDense S; S.init_tiles(M / 256, INWP / 256, Gl, bid);
            pg8::EpiInProj E{ws, KIN(3) + l * 64, KIN(4) + l * 64};
            pg8::gemm_phase<pg8::EpiInProj, pg8::SchedDense, true>(wave0, F.lds, HN, D, (gcbf)(WLP + WL_IN), D, 0, D, S, E);
            SEAM(pb + 1);
        }
        if (RUN(pb + 3)) {
            PH_IDS;
            { pg8::SchedDense S; S.init_tiles(M / 256, 3, Gl, bid); pg8::EpiUq E{ws};
              pg8::gemm_phase<pg8::EpiUq, pg8::SchedDense, true>(wave0, F.lds, LAT, LATW, (gcbf)(WLP + WL_UQ), QRANK, 0, QRANK, S, E); }
            { pg8::SchedDense S; S.init_tiles(M / 256, 2, Gl, bid); pg8::EpiUkvK E{ws, KIN(10) + l * 96};
              pg8::gemm_phase<pg8::EpiUkvK, pg8::SchedDense, true>(wave0, F.lds, LAT + QRANK, LATW, (gcbf)(WLP + WL_UKV), KVRANK, 0, KVRANK, S, E); }
            { pg8::SchedDense S; S.init_tiles(M / 256, 2, Gl, bid); pg8::EpiUkvV E{ws};
              pg8::gemm_phase<pg8::EpiUkvV, pg8::SchedDense, true>(wave0, F.lds, LAT + QRANK, LATW, (gcbf)(WLP + WL_UKV) + (size_t)512 * KVRANK, KVRANK, 0, KVRANK, S, E); }
            SEAM(pb + 3);
        }
        if (RUN(pb + 5)) {
            PH_IDS;
            int x = (int)(xb_xcc_id() & 7u), tried = 0;
#define ATT_POP() ({ if (tid == 0) F.MISC[0] = __hip_atomic_fetch_add(ctl + CW_QUEUE + 64 * (l * 8 + x), 1u, RLX_AGENT); __syncthreads(); const int v_ = __builtin_amdgcn_readfirstlane((int)F.MISC[0]); __syncthreads(); v_; })
            int it = ATT_POP();
            for (;;) {
                if (it >= 256) {
                    if (tid < 64) { const unsigned c_ = (lane < 8) ? __hip_atomic_load(ctl + CW_QUEUE + 64 * (l * 8 + lane), RLX_AGENT) : 0xffffffffu;
                        const unsigned long long bm_ = __ballot(c_ < 256u); if (tid == 0) F.MISC[0] = (unsigned)bm_; }
                    __syncthreads(); const unsigned avail_ = (unsigned)__builtin_amdgcn_readfirstlane((int)F.MISC[0]); __syncthreads();
                    if (avail_ == 0u) break;
                    x = __builtin_ctz(avail_); it = ATT_POP(); (void)tried; continue; }
                const int w = it >> 6, r = it & 63, qb = 15 - (r >> 2), st = r & 3, h = 2 * w + (st & 1), type = st >> 1, b = x;
                gu32* qp = ctl + CW_QUEUE + 64 * (l * 8 + x);
                if (type == 0) att64::attn_unit<8, 96, false>(wave0, b, h, qb, QB, KB, VB, YB, F.lds, KIN(9) + l * 96, (gcf32)(ws + WS_ROPE) + 2 * 4096 * 8, qp, F.MISC + 1);
                else att64::attn_unit<8, 64, true>(wave0, b, h, qb, QA, KA, VA, YA, F.lds, (gcf32)(ws + WS_KMP) + (size_t)b * 16 * 1024 + h * 64, (gcf32)nullptr, qp, F.MISC + 1);
                it = __builtin_amdgcn_readfirstlane((int)F.MISC[1]);
            }
#undef ATT_POP
            SEAM(pb + 5);
        }
        if (RUN(pb + 6)) {
            PH_IDS;
            static_assert(WS_YA - WS_YB == (size_t)32768 * AW * 2 && WL_BRB - WL_BRA == (size_t)D * AW * 2, "chained branch units: ya rows 32768 above yb, W_b right behind W_a");
            { pg8::SchedBranch S; S.init_tiles(M / 256, 4, Gl, bid); pg8::EpiBranch E{HN, (const GAS unsigned char*)(ws + WS_GATES)};
              pg8::gemm_phase<pg8::EpiBranch, pg8::SchedBranch, true>(wave0, F.lds, YB, AW, (gcbf)(WLP + WL_BRA), AW, D, AW, S, E); }
            SEAM(pb + 6);
        }
        if (RUN(pb + 7)) {
            PH_IDS;
            pg8::SchedDense S; S.init_tiles(M / 256, 4, Gl, bid);
            if (l == 0) { pg8::EpiResidB<true> E{(const GAS void*)KIN(0), XB};
                pg8::gemm_phase<pg8::EpiResidB<true>, pg8::SchedDense, true>(wave0, F.lds, HN, D, (gcbf)(WLP + WL_OUT), D, 0, D, S, E); }
            else { pg8::EpiResidB<false> E{(const GAS void*)XB, XB};
                pg8::gemm_phase<pg8::EpiResidB<false>, pg8::SchedDense, true>(wave0, F.lds, HN, D, (gcbf)(WLP + WL_OUT), D, 0, D, S, E); }
            SEAM(pb + 7);
        }
        if (l == 0) {
            if (RUN(pb + 8)) {
            PH_IDS;
                gcf32 g = KIN(14);
                rms_rows_bf16in(XB, g, HN, gw, NGWl, lane);
                SEAM(pb + 8);
            }
            if (RUN(pb + 9)) {
            PH_IDS;
                pg8::SchedDense S; S.init_tiles(M / 256, 22, Gl, bid); pg8::EpiSwiGLU E{(gbf)(ws + WS_ACT0)};
                pg8::gemm_phase<pg8::EpiSwiGLU, pg8::SchedDense, false>(wave0, F.lds, HN, D, (gcbf)(ws + WS_WGU), D, 0, D, S, E);
                SEAM(pb + 9);
            }
            if (RUN(pb + 10)) {
            PH_IDS;
                pg8::SchedDense S; S.init_tiles(M / 256, 4, Gl, bid); pg8::EpiResidB<false> E{(const GAS void*)XB, XB};
                pg8::gemm_phase<pg8::EpiResidB<false>, pg8::SchedDense, true>(wave0, F.lds, (gcbf)(ws + WS_ACT0), DFF, (gcbf)(ws + WS_WDN), DFF, 0, DFF, S, E);
                SEAM(pb + 10);
            }
        } else {
            if (RUN(pb + 8)) {
            PH_IDS;
                gcf32 g = KIN(14) + D; gcf32 rw = KIN(17);
                int my_e1 = -1, my_e2 = -1, my_tok = -1; float my_p1 = 0.f; int k = 0;
                float rwv[16][8];
#pragma unroll
                for (int j = 0; j < 4; ++j) { const f32x4 gvj = *(const GAS f32x4*)(g + 512 * (j >> 1) + 8 * lane + 4 * (j & 1));
#pragma unroll
                    for (int q = 0; q < 4; ++q) { const int c = 512 * (j >> 1) + 8 * lane + 4 * (j & 1) + q; const f32x4 r0 = *(const GAS f32x4*)(rw + (size_t)c * 8), r1 = *(const GAS f32x4*)(rw + (size_t)c * 8 + 4); const float gg = gvj[q];
                        rwv[4 * j + q][0] = gg * r0.x; rwv[4 * j + q][1] = gg * r0.y; rwv[4 * j + q][2] = gg * r0.z; rwv[4 * j + q][3] = gg * r0.w;
                        rwv[4 * j + q][4] = gg * r1.x; rwv[4 * j + q][5] = gg * r1.y; rwv[4 * j + q][6] = gg * r1.z; rwv[4 * j + q][7] = gg * r1.w; } }
                const int tw = (M + NGWl - 1) / NGWl;
                const int m_lo = gw * tw, m_hi = (m_lo + tw < M) ? m_lo + tw : M;
                for (int m = m_lo; m < m_hi; ++m, ++k) {
                    f32x4 v[4];
#pragma unroll
                    for (int jj = 0; jj < 2; ++jj) { const v4u w = *(const GAS v4u*)(XB + (size_t)m * D + 512 * jj + 8 * lane);
                        v[2 * jj] = (f32x4){bf_lo(w.x), bf_hi(w.x), bf_lo(w.y), bf_hi(w.y)}; v[2 * jj + 1] = (f32x4){bf_lo(w.z), bf_hi(w.z), bf_lo(w.w), bf_hi(w.w)}; }
                    float s = 0.f, lg[8];
#pragma unroll
                    for (int e = 0; e < 8; ++e) lg[e] = 0.f;
#pragma unroll
                    for (int j = 0; j < 4; ++j) { s += (v[j].x * v[j].x + v[j].y * v[j].y) + (v[j].z * v[j].z + v[j].w * v[j].w);
#pragma unroll
                        for (int q = 0; q < 4; ++q)
#pragma unroll
                            for (int e = 0; e < 8; ++e) lg[e] += v[j][q] * rwv[4 * j + q][e]; }
                    const float rstd = 1.0f / sqrtf(wave_sum(s, lane) * (1.f / D) + EPS);
                    float a4[4], b2[2], c1;
                    { const bool up = (lane & 32) != 0;
#pragma unroll
                      for (int i = 0; i < 4; ++i) { const float snd = up ? lg[i] : lg[4 + i], kp = up ? lg[4 + i] : lg[i]; a4[i] = kp + xshfl(snd, 32, lane); } }
                    { const bool up = (lane & 16) != 0;
#pragma unroll
                      for (int i = 0; i < 2; ++i) { const float snd = up ? a4[i] : a4[2 + i], kp = up ? a4[2 + i] : a4[i]; b2[i] = kp + xshfl(snd, 16, lane); } }
                    { const bool up = (lane & 8) != 0; const float snd = up ? b2[0] : b2[1], kp = up ? b2[1] : b2[0]; c1 = kp + xshfl(snd, 8, lane); }
                    c1 += xshfl(c1, 4, lane); c1 += xshfl(c1, 2, lane); c1 += xshfl(c1, 1, lane);
                    float lgs[8];
#pragma unroll
                    for (int e = 0; e < 8; ++e) lgs[e] = rstd * __int_as_float(__builtin_amdgcn_readlane(__float_as_int(c1), 8 * e));
#pragma unroll
                    for (int jj = 0; jj < 2; ++jj) { const f32x4 h0 = v[2 * jj] * rstd * *(const GAS f32x4*)(g + 512 * jj + 8 * lane), h1 = v[2 * jj + 1] * rstd * *(const GAS f32x4*)(g + 512 * jj + 8 * lane + 4);
                        v4u w; w.x = cvt_pk_bf16(h0.x, h0.y); w.y = cvt_pk_bf16(h0.z, h0.w); w.z = cvt_pk_bf16(h1.x, h1.y); w.w = cvt_pk_bf16(h1.z, h1.w);
                        *(GAS v4u*)(HN + (size_t)m * D + 512 * jj + 8 * lane) = w; }
                    float v1 = lgs[0]; int e1 = 0;
#pragma unroll
                    for (int e = 1; e < 8; ++e) if (lgs[e] > v1) { v1 = lgs[e]; e1 = e; }
                    float v2 = -INFINITY; int e2 = 0;
#pragma unroll
                    for (int e = 0; e < 8; ++e) if (e != e1 && lgs[e] > v2) { v2 = lgs[e]; e2 = e; }
                    const float p1 = 1.0f / (1.0f + expf(v2 - v1));
                    if (lane == k) { my_e1 = e1; my_e2 = e2; my_tok = m; my_p1 = p1; }
                }
                GAS int* WCNT = (GAS int*)(ws + WS_WCNT);
                { int myc = 0;
#pragma unroll
                  for (int e = 0; e < 8; ++e) { const int c = __popcll(__ballot(my_e1 == e)) + __popcll(__ballot(my_e2 == e)); if (lane == e) myc = c; }
                  if (lane < 8) WCNT[gw * 8 + lane] = myc; }
                if (my_tok >= 0) { TOKP[my_tok * 2] = my_p1; TOKP[my_tok * 2 + 1] = 1.0f - my_p1; }
                __syncthreads();
                int rot = 0;
                for (int e = 0; e < NEXP; ++e) {
                    conv_job(F, NGWl, lane, wave, gw, KIN(18) + (size_t)e * D * 2 * DFF, D, 2 * DFF, (gbf)(ws + WS_WEGU) + (size_t)e * 2 * DFF * D, 2, rot);
                    conv_job(F, NGWl, lane, wave, gw, KIN(19) + (size_t)e * DFF * D, DFF, D, (gbf)(ws + WS_WEDN) + (size_t)e * D * DFF, 0, rot, nullptr, -0.6931471805599453f);
                }
                xcd_barrier(bar, wave0);
                { int pre[8], tot[8];
#pragma unroll
                  for (int e = 0; e < 8; ++e) { pre[e] = 0; tot[e] = 0; }
                  for (int w0 = lane; w0 < NGWl; w0 += 64) { const GAS v4u* cp = (const GAS v4u*)(WCNT + w0 * 8); const v4u c0 = cp[0], c1 = cp[1];
                      const int cc[8] = {(int)c0.x, (int)c0.y, (int)c0.z, (int)c0.w, (int)c1.x, (int)c1.y, (int)c1.z, (int)c1.w};
#pragma unroll
                      for (int e = 0; e < 8; ++e) { tot[e] += cc[e]; if (w0 < gw) pre[e] += cc[e]; } }
#pragma unroll
                  for (int e = 0; e < 8; ++e) {
#pragma unroll
                      for (int o = 1; o < 64; o <<= 1) { pre[e] += __builtin_amdgcn_ds_bpermute((lane ^ o) << 2, pre[e]); tot[e] += __builtin_amdgcn_ds_bpermute((lane ^ o) << 2, tot[e]); } }
                  const unsigned long long below = (1ull << lane) - 1ull;
#pragma unroll
                  for (int e = 0; e < 8; ++e) { const unsigned long long m1 = __ballot(my_e1 == e), m2 = __ballot(my_e2 == e); const int c1 = __popcll(m1);
                      if (my_e1 == e) ELIST[e * 32768 + pre[e] + __popcll(m1 & below)] = my_tok * 2;
                      if (my_e2 == e) ELIST[e * 32768 + pre[e] + c1 + __popcll(m2 & below)] = my_tok * 2 + 1;
                      if (gw == 0 && lane == 0) __hip_atomic_store(ctl + CW_ECNT + 64 * e, (unsigned)tot[e], RLX_AGENT); } }
                SEAM(pb + 8);
            }
            if (RUN(pb + 9) || RUN(pb + 10)) {
                PH_IDS;
                if (tid == 0) { int off = 0;
                    for (int e = 0; e < 8; ++e) { const int c = (int)__hip_atomic_load(ctl + CW_ECNT + 64 * e, RLX_AGENT); F.MISC[16 + e] = (unsigned)off; F.MISC[32 + e] = (unsigned)c; off += (c + 255) >> 8; }
                    F.MISC[24] = (unsigned)off; }
                __syncthreads();
            }
            const volatile LAS int* tab = (const volatile LAS int*)(F.MISC + 16);
            if (RUN(pb + 9)) {
            PH_IDS;
                pg8::SchedMoe S; S.init_tiles(__builtin_amdgcn_readfirstlane(tab[8]), 22, Gl, bid); S.tab = tab; S.list = ELIST; S.gather = 1;
                pg8::EpiSwiGLU E{(gbf)(ws + WS_ACT1)};
                pg8::gemm_phase<pg8::EpiSwiGLU, pg8::SchedMoe, false>(wave0, F.lds, HN, D, (gcbf)(ws + WS_WEGU), D, 2 * DFF, D, S, E);
                SEAM(pb + 9);
            }
            if (RUN(pb + 10)) {
            PH_IDS;
                pg8::SchedMoe S; S.init_tiles(__builtin_amdgcn_readfirstlane(tab[8]), 4, Gl, bid); S.tab = tab; S.list = ELIST; S.gather = 0;
                pg8::EpiMoeDown E{(gbf)(ws + WS_Y), tab, ELIST, TOKP};
                pg8::gemm_phase<pg8::EpiMoeDown, pg8::SchedMoe, true>(wave0, F.lds, (gcbf)(ws + WS_ACT1), DFF, (gcbf)(ws + WS_WEDN), DFF, D, DFF, S, E);
                SEAM(pb + 10);
            }
            if (RUN(pb + 11)) {
            PH_IDS;
                gcbf Y0 = (gcbf)(ws + WS_Y); gcbf Y1 = Y0 + (size_t)M * D;
                const unsigned bad = __hip_atomic_load((gu32*)(ctl + CW_BAR + XB_TMO), RLX_AGENT);
                const size_t n8 = (size_t)M * D / 8;
                for (size_t i = (size_t)bid * 512 + tid; i < n8; i += (size_t)Gl * 512) {
                    float a[8], c[8]; unpack8(*(const GAS v4u*)(Y0 + i * 8), a); unpack8(*(const GAS v4u*)(Y1 + i * 8), c);
                    float xs[8]; unpack8(*(const GAS v4u*)(XB + i * 8), xs);
                    f32x4 x0 = (f32x4){xs[0], xs[1], xs[2], xs[3]}, x1 = (f32x4){xs[4], xs[5], xs[6], xs[7]};
                    x0.x += a[0] + c[0]; x0.y += a[1] + c[1]; x0.z += a[2] + c[2]; x0.w += a[3] + c[3];
                    x1.x += a[4] + c[4]; x1.y += a[5] + c[5]; x1.z += a[6] + c[6]; x1.w += a[7] + c[7];
                    if (bad) { const float q = __builtin_nanf(""); x0 = (f32x4){q, q, q, q}; x1 = x0; }
                    *(GAS f32x4*)(OUT + i * 8) = x0; *(GAS f32x4*)(OUT + i * 8 + 4) = x1;
                }
            }
        }
    }
#undef RUN
#undef SEAM
}

extern "C" void kernel_launch(void* const* d_in, const int* in_sizes, int n_in, void* d_out, int out_size, void* d_ws, size_t ws_size, hipStream_t stream) {
    static int grid = 0;
    if (grid == 0) {
        if (n_in != 20 || out_size != M * D || ws_size < WS_END) { fprintf(stderr, "kernel_launch: unexpected sizes n_in %d out %d ws %zu (need %zu)\n", n_in, out_size, ws_size, (size_t)WS_END); grid = -1; return; }
        int dev = 0, cus = 0, per_cu = 0;
        if (hipGetDevice(&dev) != hipSuccess || hipDeviceGetAttribute(&cus, hipDeviceAttributeMultiprocessorCount, dev) != hipSuccess) { grid = -1; return; }
        if (hipFuncSetAttribute((const void*)mk_fwd, hipFuncAttributeMaxDynamicSharedMemorySize, LDS_BYTES) != hipSuccess) { fprintf(stderr, "kernel_launch: hipFuncSetAttribute failed\n"); grid = -1; return; }
        if (hipOccupancyMaxActiveBlocksPerMultiprocessor(&per_cu, (const void*)mk_fwd, NWAVES * 64, LDS_BYTES) != hipSuccess || per_cu < 1) fprintf(stderr, "kernel_launch: occupancy query says %d\n", per_cu);
        (void)hipGetLastError();
        grid = cus;
    }
    if (grid < 0) return;
    if (hipMemsetAsync((char*)d_ws + WS_CTL, 0, CTL_ZERO_BYTES, stream) != hipSuccess) return;
    Args a{};
    for (int i = 0; i < 20; ++i) a.in[i] = (const float*)d_in[i];
    a.out = (float*)d_out; a.ws = (unsigned char*)d_ws;
#if MK_SPLIT
    for (int p = 0; p < NPH; ++p) { a.ph_lo = p; a.ph_hi = p + 1; hipLaunchKernelGGL(mk_fwd, dim3(grid), dim3(NWAVES * 64), LDS_BYTES, stream, a); }
#else
    a.ph_lo = 0; a.ph_hi = NPH;
    hipLaunchKernelGGL(mk_fwd, dim3(grid), dim3(NWAVES * 64), LDS_BYTES, stream, a);
#endif
}
```
